# Optimizing an MI355X kernel written in HIP

```python
import jax
import jax.numpy as jnp
from jax import lax
import numpy as np

D_MODEL = 2048
BATCH = 4
SEQ = 2048
DEPTH = 1

CTX_LEN = 256
GRID_W = 64
GLA_HEADS = 4
GLA_DK = 128
GLA_DV = 256
GLA_GATE_RANK = 16
GLA_GATE_TAU = 16.0
GLA_CHUNK = 64
FNET_GROUPS = 4
FNET_GROUP_DIM = 256
D_FF = 5632
CONV_W = 3
EPS = 1e-6

QK_W = GLA_HEADS * GLA_DK
V_W = GLA_HEADS * GLA_DV
FNET_W = FNET_GROUPS * FNET_GROUP_DIM
IN_SIZES = (QK_W, QK_W, V_W, V_W, GLA_GATE_RANK, GLA_GATE_RANK, FNET_W, D_MODEL, D_MODEL)
IN_OFFSETS = tuple(int(o) for o in np.cumsum((0,) + IN_SIZES))
IN_W = IN_OFFSETS[-1]

kernel_name = 'hybrid_gla_fnet_convffn_dit'


def rmsnorm(x, g):
    xf = x.astype(jnp.float32)
    y = xf * lax.rsqrt(jnp.mean(xf * xf, axis=-1, keepdims=True) + EPS)
    return (y * g.astype(jnp.float32)).astype(x.dtype)


def adaln(cond, w, b):
    mod = jax.nn.silu(cond) @ w + b
    return [m[:, None, :] for m in jnp.split(mod, 6, axis=-1)]


def modulate(h, shift, scale):
    return h * (1 + scale) + shift


def to_heads(t):
    bsz, T, _ = t.shape
    return t.reshape(bsz, T, GLA_HEADS, -1).transpose(0, 2, 1, 3).astype(jnp.float32)


def flip_time(t):
    return jnp.flip(t, axis=2)


def gla_log_decay(lr, w, b):
    return to_heads(jax.nn.log_sigmoid((lr @ w + b).astype(jnp.float32)) / GLA_GATE_TAU)


def gla_chunked(q, k, v, log_a, s0):
    bsz, H, T, dk = q.shape
    C = GLA_CHUNK
    N = T // C
    q, k, v, log_a = (t.reshape(bsz, H, N, C, t.shape[-1]) for t in (q, k, v, log_a))
    b = jnp.cumsum(log_a, axis=3)
    b_last = b[:, :, :, -1:, :]
    q_dec = q * jnp.exp(b)
    k_dec = k * jnp.exp(-b)
    k_state = k * jnp.exp(b_last - b)
    mask = jnp.tril(jnp.ones((C, C), dtype=bool))
    scores = jnp.where(mask, jnp.einsum('bhncd,bhnsd->bhncs', q_dec, k_dec), 0.0)
    o_intra = jnp.einsum('bhncs,bhnsv->bhncv', scores, v)
    kv = jnp.einsum('bhncd,bhncv->nbhdv', k_state, v)
    decay = jnp.moveaxis(jnp.exp(b_last[:, :, :, 0, :]), 2, 0)

    def step(s, inp):
        dec, kv_n = inp
        return dec[..., None] * s + kv_n, s

    s_final, s_prev = lax.scan(step, s0, (decay, kv))
    o_inter = jnp.einsum('bhncd,nbhdv->bhncv', q_dec, s_prev)
    return (o_intra + o_inter).reshape(bsz, H, T, -1), s_final


def gla_final_state(k, v, log_a):
    b = jnp.cumsum(log_a, axis=2)
    w = jnp.exp(b[:, :, -1:, :] - b)
    return jnp.einsum('bhtd,bhtv->bhdv', k * w, v)


def token_mixer(h, w_in, w_gate_f, b_gate_f, w_gate_b, b_gate_b, g_gla,
                w_gla_out, w_fnet_out, w_out, s0_f, s0_b):
    bsz, T, _ = h.shape
    proj = h @ w_in
    q, k, v, r, lr_f, lr_b, f_in, g_a, g_b = jnp.split(proj, IN_OFFSETS[1:-1], axis=-1)
    qh = to_heads(q) * (GLA_DK ** -0.5)
    kh, vh = to_heads(k), to_heads(v)
    la_f = gla_log_decay(lr_f, w_gate_f, b_gate_f)
    la_b = gla_log_decay(lr_b, w_gate_b, b_gate_b)
    o_f, s_f = gla_chunked(qh, kh, vh, la_f, s0_f)
    o_b, s_b = gla_chunked(flip_time(qh), flip_time(kh), flip_time(vh), flip_time(la_b), s0_b)
    o = o_f + flip_time(o_b)
    o = o * lax.rsqrt(jnp.mean(o * o, axis=-1, keepdims=True) + EPS)
    o = o.transpose(0, 2, 1, 3).reshape(bsz, T, V_W) * g_gla.astype(jnp.float32)
    y_a = (jax.nn.silu(r.astype(jnp.float32)) * o).astype(h.dtype) @ w_gla_out
    f = f_in.astype(jnp.float32).reshape(bsz, T, FNET_GROUPS, FNET_GROUP_DIM)
    f = jnp.fft.fft2(f, axes=(1, 3), norm='ortho').real.reshape(bsz, T, FNET_W)
    y_b = f.astype(h.dtype) @ w_fnet_out
    y = jax.nn.sigmoid(g_a) * y_a + jax.nn.sigmoid(g_b) * y_b
    return y @ w_out, s_f, s_b


def context_gla_states(hc, w_in, w_gate_f, b_gate_f, w_gate_b, b_gate_b):
    def cols(i):
        return hc @ w_in[:, IN_OFFSETS[i]:IN_OFFSETS[i + 1]]
    kh, vh = to_heads(cols(1)), to_heads(cols(2))
    la_f = gla_log_decay(cols(4), w_gate_f, b_gate_f)
    la_b = gla_log_decay(cols(5), w_gate_b, b_gate_b)
    s_f = gla_final_state(kh, vh, la_f)
    s_b = gla_final_state(flip_time(kh), flip_time(vh), flip_time(la_b))
    return s_f, s_b


def dwconv_rows(u, w, b, n_rows, row_len):
    bsz, T, ch = u.shape
    p = jnp.pad(u.reshape(bsz, n_rows, row_len, ch), ((0, 0), (0, 0), (1, 1), (0, 0)))
    y = p[:, :, :-2] * w[0] + p[:, :, 1:-1] * w[1] + p[:, :, 2:] * w[2] + b
    return y.reshape(bsz, T, ch)


def conv_ffn(h, w_up, conv_w, conv_b, w_down, n_rows, row_len):
    u = dwconv_rows(h @ w_up, conv_w, conv_b, n_rows, row_len)
    val, gate = jnp.split(u, 2, axis=-1)
    return (jax.nn.silu(gate) * val) @ w_down


def setup_inputs(seed: int = 0) -> dict:
    key = jax.random.key(seed)
    ks = jax.random.split(key, 24)
    L, D, F2 = DEPTH, D_MODEL, 2 * D_FF

    def nrm(k, shape, fan):
        return jax.random.normal(k, shape, jnp.float32) * (fan ** -0.5)

    def gain(k, shape):
        return 1.0 + 0.02 * jax.random.normal(k, shape, jnp.float32)

    def bias(k, shape):
        return 0.02 * jax.random.normal(k, shape, jnp.float32)

    return {
        'x': jax.random.normal(ks[0], (BATCH, SEQ, D), jnp.float32),
        'c': jax.random.normal(ks[1], (BATCH, D), jnp.float32),
        'ctx': jax.random.normal(ks[2], (BATCH, CTX_LEN, D), jnp.float32),
        'c_ctx': jax.random.normal(ks[3], (D,), jnp.float32),
        'w_ada': nrm(ks[4], (L, D, 6 * D), D),
        'b_ada': bias(ks[5], (L, 6 * D)),
        'g_norm1': gain(ks[6], (L, D)),
        'w_in': nrm(ks[7], (L, D, IN_W), D),
        'w_gate_f': nrm(ks[8], (L, GLA_GATE_RANK, QK_W), GLA_GATE_RANK),
        'b_gate_f': bias(ks[9], (L, QK_W)),
        'w_gate_b': nrm(ks[10], (L, GLA_GATE_RANK, QK_W), GLA_GATE_RANK),
        'b_gate_b': bias(ks[11], (L, QK_W)),
        'g_gla': gain(ks[12], (L, V_W)),
        'w_gla_out': nrm(ks[13], (L, V_W, D), V_W),
        'w_fnet_out': nrm(ks[14], (L, FNET_W, D), FNET_W),
        'w_out': nrm(ks[15], (L, D, D), D),
        'g_norm2': gain(ks[16], (L, D)),
        'w_up': nrm(ks[17], (L, D, F2), D),
        'conv_w': nrm(ks[18], (L, CONV_W, F2), CONV_W),
        'conv_b': bias(ks[19], (L, F2)),
        'w_down': nrm(ks[20], (L, D_FF, D), D_FF),
        'g_final': gain(ks[21], (D,)),
    }


def reference(x, c, ctx, c_ctx, w_ada, b_ada, g_norm1, w_in, w_gate_f, b_gate_f,
              w_gate_b, b_gate_b, g_gla, w_gla_out, w_fnet_out, w_out, g_norm2,
              w_up, conv_w, conv_b, w_down, g_final):
    rows = x.shape[1] // GRID_W
    ctx_len = ctx.shape[1]
    for l in range(DEPTH):
        sh1, sc1, gt1, sh2, sc2, gt2 = adaln(c, w_ada[l], b_ada[l])
        csh1, csc1, cgt1, csh2, csc2, cgt2 = adaln(c_ctx[None, :], w_ada[l], b_ada[l])
        mix_w = (w_in[l], w_gate_f[l], b_gate_f[l], w_gate_b[l], b_gate_b[l], g_gla[l],
                 w_gla_out[l], w_fnet_out[l], w_out[l])
        hc = modulate(rmsnorm(ctx, g_norm1[l]), csh1, csc1)
        if l < DEPTH - 1:
            zeros = jnp.zeros((ctx.shape[0], GLA_HEADS, GLA_DK, GLA_DV), jnp.float32)
            yc, s_f, s_b = token_mixer(hc, *mix_w, zeros, zeros)
            ctx = ctx + cgt1 * yc
            hc2 = modulate(rmsnorm(ctx, g_norm2[l]), csh2, csc2)
            ctx = ctx + cgt2 * conv_ffn(hc2, w_up[l], conv_w[l], conv_b[l], w_down[l], 1, ctx_len)
        else:
            s_f, s_b = context_gla_states(hc, w_in[l], w_gate_f[l], b_gate_f[l],
                                          w_gate_b[l], b_gate_b[l])
        hx = modulate(rmsnorm(x, g_norm1[l]), sh1, sc1)
        yx, _, _ = token_mixer(hx, *mix_w, s_f, s_b)
        x = x + gt1 * yx
        hx2 = modulate(rmsnorm(x, g_norm2[l]), sh2, sc2)
        x = x + gt2 * conv_ffn(hx2, w_up[l], conv_w[l], conv_b[l], w_down[l], rows, GRID_W)
    return rmsnorm(x, g_final)
```

```cpp
#include <hip/hip_runtime.h>
#include <hip/hip_cooperative_groups.h>
#include <cstdio>
#include <cstdint>
namespace cg = cooperative_groups;

#ifndef GEMM_FAST
#define GEMM_FAST 1
#endif

#define LAS __attribute__((address_space(3)))
typedef unsigned short bf16_t;
typedef short bf16x8 __attribute__((ext_vector_type(8)));
typedef float f32x4 __attribute__((ext_vector_type(4)));
typedef unsigned u32x4 __attribute__((ext_vector_type(4)));
typedef unsigned u32x2 __attribute__((ext_vector_type(2)));

constexpr int DM = 2048, NB = 4, SEQ = 2048, M = NB * SEQ, CTX = 256, MC = NB * CTX, MT = M + MC;
constexpr int NH = 4, DK = 128, DV = 256, RANK = 16, FF = 5632, F2 = 2 * FF, INW = 8224, NPROJ = 8448;
constexpr int QKW = 512, VW = 1024, FNW = 1024, MODW = 6 * DM;
constexpr float EPS = 1e-6f;
enum { I_X = 0, I_C, I_CTX, I_CCTX, I_WADA, I_BADA, I_G1, I_WIN, I_WGF, I_BGF, I_WGB, I_BGB, I_GGLA, I_WGLA, I_WFN, I_WOUT, I_G2, I_WUP, I_CW, I_CB, I_WDN, I_GF, N_IN };

constexpr size_t MiB = 1u << 20;
constexpr size_t CTL_ZERO_BYTES = 1 * MiB;
constexpr size_t OFF_MOD = 65536;
constexpr size_t OFF_WIN = 1 * MiB;
constexpr size_t OFF_WGLA = 34 * MiB;
constexpr size_t OFF_WFN = 38 * MiB;
constexpr size_t OFF_WO = 42 * MiB;
constexpr size_t OFF_WUP = 50 * MiB;
constexpr size_t OFF_WD = 94 * MiB;
constexpr size_t OFF_DT = 116 * MiB;
constexpr size_t OFF_CS = 132 * MiB;
constexpr size_t OFF_A = 133 * MiB;
constexpr size_t OFF_Q = 169 * MiB;
constexpr size_t OFF_K = 177 * MiB;
constexpr size_t OFF_V = 186 * MiB;
constexpr size_t OFF_R = 204 * MiB;
constexpr size_t OFF_F = 220 * MiB;
constexpr size_t OFF_GA = 236 * MiB;
constexpr size_t OFF_GB = 268 * MiB;
constexpr size_t OFF_LR = 300 * MiB;
constexpr size_t OFF_FF = 305 * MiB;
constexpr size_t OFF_OF = 321 * MiB;
constexpr size_t OFF_OB = 353 * MiB;
constexpr size_t WS_END = 385 * MiB;
constexpr size_t OFF_U = 169 * MiB;
constexpr size_t OFF_ACT = 257 * MiB;

constexpr int LDS_BYTES = 147456;
constexpr int NTHR = 512;

__device__ __forceinline__ float bf2f(unsigned short h) { return __uint_as_float((unsigned)h << 16); }
__device__ __forceinline__ unsigned f2bf(float f) { unsigned u = __float_as_uint(f); return (u + 0x7fffu + ((u >> 16) & 1u)) >> 16; }
typedef __bf16 bf16v2_t __attribute__((ext_vector_type(2)));
__device__ __forceinline__ unsigned pk2hw(float lo, float hi) { bf16v2_t v; v[0] = (__bf16)lo; v[1] = (__bf16)hi; return __builtin_bit_cast(unsigned, v); }
__device__ __forceinline__ unsigned pk2(float lo, float hi) { return pk2hw(lo, hi); }
__device__ __forceinline__ unsigned f2bfhw(float f) { return (unsigned)__builtin_bit_cast(unsigned short, (__bf16)f); }
__device__ __forceinline__ f32x4 ld_bf4(const bf16_t* p) { u32x2 w = *(const u32x2*)p; return (f32x4){__uint_as_float(w.x << 16), __uint_as_float(w.x & 0xffff0000u), __uint_as_float(w.y << 16), __uint_as_float(w.y & 0xffff0000u)}; }
__device__ __forceinline__ void st_bf4(bf16_t* p, f32x4 v) { u32x2 w; w.x = pk2(v[0], v[1]); w.y = pk2(v[2], v[3]); *(u32x2*)p = w; }
__device__ __forceinline__ float sigmoidf_(float x) { return __builtin_amdgcn_rcpf(1.f + __expf(-x)); }
__device__ __forceinline__ float wave_sum(float v) {
#pragma unroll
    for (int o = 1; o < 64; o <<= 1) v += __shfl_xor(v, o);
    return v;
}

constexpr int BM = 256, BK = 64, HALF = 128, HTB = HALF * BK * 2, NXCD = 8, WGM = 8;
struct Unit { int pm, pn, bz; };
struct GemmP {
    const bf16_t* A; const bf16_t* Bt; int lda, ldb, K; long sB1, sB2, sA2;
    __device__ __forceinline__ const bf16_t* aptr(const Unit& u) const { return A + (size_t)(u.bz & 3) * sA2 + (size_t)u.pm * BM * lda; }
    __device__ __forceinline__ const bf16_t* bptr(const Unit& u) const { return Bt + (size_t)(u.bz >> 2) * sB1 + (size_t)(u.bz & 3) * sB2 + (size_t)u.pn * BM * ldb; }
};
struct SchedGrid {
    int nMt, nN, nMb, G, c;
    __device__ __forceinline__ bool decode(int L, Unit& u) const {
        const int nwg = nMt * nN; if (L >= nwg) return false;
        int wgid = L; { const int q = nwg / NXCD, r = nwg % NXCD, xcd = wgid % NXCD, off = wgid / NXCD; wgid = (xcd < r ? xcd * (q + 1) : r * (q + 1) + (xcd - r) * q) + off; }
        const int nig = WGM * nN, gid = wgid / nig, fm = gid * WGM, gsz = (nMt - fm) < WGM ? (nMt - fm) : WGM;
        const int pmt = fm + ((wgid % nig) % gsz); u.pn = (wgid % nig) / gsz; u.bz = pmt / nMb; u.pm = pmt % nMb; return true;
    }
    __device__ __forceinline__ bool next(int i, Unit& u) const { return decode(i * G + c, u); }
};
struct SchedProj {
    SchedGrid g;
    __device__ __forceinline__ bool next(int i, Unit& u) const {
        const int L = i * g.G + g.c;
        if (L < 32 * 33) return g.decode(L, u);
        const int j = L - 32 * 33; if (j >= 28) return false;
        const int t = j >> 2; u.pm = 32 + (j & 3); u.pn = t < 6 ? t + 2 : 32; u.bz = 0; return true;
    }
};

struct EpiProj { static constexpr bool TILE = false;
    bf16_t *Q, *Kb, *Vb, *R, *F, *GA, *GB, *LR;
    __device__ __forceinline__ void put(const Unit& u, int row, int col, f32x4 v) const {
        const int pn = u.pn; bf16_t* base; int ldc, c0, act = 0;
        if (pn < 2) { base = Q; ldc = 512; c0 = 0; act = 1; }
        else if (pn < 4) { base = Kb; ldc = 512; c0 = 512; }
        else if (pn < 8) { base = Vb; ldc = 1024; c0 = 1024; }
        else if (pn < 12) { base = R; ldc = 1024; c0 = 2048; act = 2; }
        else if (pn < 16) { base = F; ldc = 1024; c0 = 3072; }
        else if (pn < 24) { base = GA; ldc = 2048; c0 = 4096; act = 3; }
        else if (pn < 32) { base = GB; ldc = 2048; c0 = 6144; act = 3; }
        else { base = LR; ldc = 256; c0 = 8192; }
        if (act == 1) v = v * 0.08838834764831845f;
        else if (act == 2) { v[0] *= sigmoidf_(v[0]); v[1] *= sigmoidf_(v[1]); v[2] *= sigmoidf_(v[2]); v[3] *= sigmoidf_(v[3]); }
        else if (act == 3) { v[0] = sigmoidf_(v[0]); v[1] = sigmoidf_(v[1]); v[2] = sigmoidf_(v[2]); v[3] = sigmoidf_(v[3]); }
        st_bf4(base + (size_t)row * ldc + (col - c0), v);
    }
};
struct EpiFn1 { static constexpr bool TILE = false; bf16_t* XT;
    __device__ __forceinline__ void put(const Unit& u, int row, int col, f32x4 v) const {
        st_bf4(XT + (size_t)u.bz * 256 * 4096 + (size_t)(row & 255) * 4096 + (row >> 8) * 2048 + col, v); } };
struct EpiFn2 { static constexpr bool TILE = false; bf16_t* Ff; float scale;
    __device__ __forceinline__ void put(const Unit& u, int row, int col, f32x4 v) const {
        st_bf4(Ff + (size_t)((u.bz >> 2) * SEQ + row) * FNW + (u.bz & 3) * 256 + col, v * scale); } };
struct EpiFn2S { static constexpr bool TILE = false; bf16_t* Ff; float scale;
    __device__ __forceinline__ void put(const Unit& u, int row, int col, f32x4 v) const {
        st_bf4(Ff + (size_t)((u.bz >> 2) * SEQ + row) * FNW + (u.bz & 3) * 256 + col, v * scale); } };
struct SchedPair { SchedGrid g;
    __device__ __forceinline__ bool next(int i, Unit& u) const { if (i >= 2) return false; const bool ok = g.decode(g.c, u); u.bz = i; return ok; } };
struct EpiYab { static constexpr bool TILE = false; const bf16_t* GA; const bf16_t* GB; float* YA; bf16_t* Y;
    __device__ __forceinline__ void put(const Unit& u, int row, int col, f32x4 v) const {
        const size_t o = (size_t)row * DM + col;
        if (u.bz == 0) st_bf4((bf16_t*)YA + o, ld_bf4(GA + o) * v);
        else st_bf4(Y + o, ld_bf4((const bf16_t*)YA + o) + ld_bf4(GB + o) * v); } };
struct EpiYa { static constexpr bool TILE = false; const bf16_t* GA; float* YA;
    __device__ __forceinline__ void put(const Unit& u, int row, int col, f32x4 v) const {
        const size_t o = (size_t)row * DM + col; *(f32x4*)(YA + o) = ld_bf4(GA + o) * v; } };
struct EpiYb { static constexpr bool TILE = false; const bf16_t* GB; const float* YA; bf16_t* Y;
    __device__ __forceinline__ void put(const Unit& u, int row, int col, f32x4 v) const {
        const size_t o = (size_t)row * DM + col; st_bf4(Y + o, *(const f32x4*)(YA + o) + ld_bf4(GB + o) * v); } };
struct EpiOut { static constexpr bool TILE = false; const float* x; const float* mod; float* X1;
    __device__ __forceinline__ void put(const Unit& u, int row, int col, f32x4 v) const {
        const size_t o = (size_t)row * DM + col; const f32x4 gt = *(const f32x4*)(mod + (row >> 11) * MODW + 2 * DM + col);
        *(f32x4*)(X1 + o) = *(const f32x4*)(x + o) + gt * v; } };
struct EpiUp { static constexpr bool TILE = false; bf16_t* U;
    __device__ __forceinline__ void put(const Unit& u, int row, int col, f32x4 v) const { st_bf4(U + (size_t)row * F2 + col, v); } };
struct EpiDown { static constexpr bool TILE = false; const float* mod; float* X;
    __device__ __forceinline__ void put(const Unit& u, int row, int col, f32x4 v) const {
        const size_t o = (size_t)row * DM + col; const f32x4 gt = *(const f32x4*)(mod + (row >> 11) * MODW + 5 * DM + col);
        *(f32x4*)(X + o) = *(const f32x4*)(X + o) + gt * v; } };

__device__ __forceinline__ float dpp_ror1(float v) { return __int_as_float(__builtin_amdgcn_update_dpp(0, __float_as_int(v), 0x121, 0xf, 0xf, false)); }
__device__ __forceinline__ float dpp_rol1(float v) { return __int_as_float(__builtin_amdgcn_update_dpp(0, __float_as_int(v), 0x12F, 0xf, 0xf, false)); }
struct EpiUpConv { static constexpr bool TILE = true;
    const float* cw; const float* cb; bf16_t* ACT;
    __device__ __forceinline__ void put(const Unit&, int, int, f32x4) const {}
    __device__ __forceinline__ void tile(const f32x4 (&acc)[2][2][4][2], const Unit& u, int wr, int wc, int fr, int fq) const {
#pragma unroll
        for (int n = 0; n < 2; ++n) {
            const int cv = 128 * u.pn + 32 * wc + 16 * n + 4 * fq, cg = FF + cv;
            const f32x4 wv0 = *(const f32x4*)(cw + cv), wv1 = *(const f32x4*)(cw + F2 + cv), wv2 = *(const f32x4*)(cw + 2 * F2 + cv), bv = *(const f32x4*)(cb + cv);
            const f32x4 wg0 = *(const f32x4*)(cw + cg), wg1 = *(const f32x4*)(cw + F2 + cg), wg2 = *(const f32x4*)(cw + 2 * F2 + cg), bg = *(const f32x4*)(cb + cg);
#pragma unroll
            for (int ai = 0; ai < 2; ++ai)
#pragma unroll
                for (int m = 0; m < 4; ++m) {
                    f32x4 r;
#pragma unroll
                    for (int i = 0; i < 4; ++i) {
                        const float xv = acc[ai][0][m][n][i], xg = acc[ai][1][m][n][i];
                        const float uv = m > 0 ? acc[ai][0][m > 0 ? m - 1 : 0][n][i] : 0.f, ug = m > 0 ? acc[ai][1][m > 0 ? m - 1 : 0][n][i] : 0.f;
                        const float dv = m < 3 ? acc[ai][0][m < 3 ? m + 1 : 3][n][i] : 0.f, dg = m < 3 ? acc[ai][1][m < 3 ? m + 1 : 3][n][i] : 0.f;
                        const float pv = dpp_ror1(fr == 15 ? uv : xv), pg = dpp_ror1(fr == 15 ? ug : xg);
                        const float nv = dpp_rol1(fr == 0 ? dv : xv), ng = dpp_rol1(fr == 0 ? dg : xg);
                        const float yv = wv0[i] * pv + wv1[i] * xv + wv2[i] * nv + bv[i];
                        const float yg = wg0[i] * pg + wg1[i] * xg + wg2[i] * ng + bg[i];
                        r[i] = yg * sigmoidf_(yg) * yv;
                    }
                    st_bf4(ACT + (size_t)(u.pm * BM + ai * HALF + wr * 64 + m * 16 + fr) * FF + cv, r);
                }
        }
    }
};

template <class Epi, class Sched>
__device__ __forceinline__ void gemm_naive(const GemmP g, const Sched& S, const Epi& E) {
    const int tid = threadIdx.x, rg = tid >> 3, cgi = tid & 7;
    Unit u;
    for (int i = 0; S.next(i, u); ++i) {
        const bf16_t* A = g.aptr(u) + (size_t)(rg * 4) * g.lda; const bf16_t* B = g.bptr(u);
        for (int j = 0; j < 8; ++j) {
            const int c = j * 32 + cgi * 4;
            const bf16_t* Bc = B + (size_t)c * g.ldb;
            float acc[4][4];
#pragma unroll
            for (int r = 0; r < 4; ++r)
#pragma unroll
                for (int cc = 0; cc < 4; ++cc) acc[r][cc] = 0.f;
            for (int k = 0; k < g.K; k += 8) {
                bf16x8 a[4], b[4];
#pragma unroll
                for (int r = 0; r < 4; ++r) { a[r] = *(const bf16x8*)(A + (size_t)r * g.lda + k); b[r] = *(const bf16x8*)(Bc + (size_t)r * g.ldb + k); }
#pragma unroll
                for (int e = 0; e < 8; ++e)
#pragma unroll
                    for (int r = 0; r < 4; ++r)
#pragma unroll
                        for (int cc = 0; cc < 4; ++cc) acc[r][cc] += bf2f((unsigned short)a[r][e]) * bf2f((unsigned short)b[cc][e]);
            }
#pragma unroll
            for (int r = 0; r < 4; ++r) E.put(u, u.pm * BM + rg * 4 + r, u.pn * BM + c, (f32x4){acc[r][0], acc[r][1], acc[r][2], acc[r][3]});
        }
    }
}

__device__ __forceinline__ int lds_byte(int r, int c) { const int st = (r >> 4) * 2 + (c >> 5), rr = r & 15, cc = c & 31, ob = rr * 64 + cc * 2; return st * 1024 + (ob ^ (((ob >> 9) & 1) << 5)); }
__device__ __forceinline__ void stage_rc(int b, int& R, int& C) { const int st = b / 1024, sb = b % 1024, swz = sb ^ (((sb >> 9) & 1) << 5); R = (st >> 1) * 16 + swz / 64; C = (st & 1) * 32 + (swz % 64) / 2; }

template <class Epi, class Sched, bool DEFER>
__device__ __forceinline__ void gemm_fast_core(LAS unsigned char* lds, const GemmP g, const Sched& S, const Epi& E, f32x4 (&acc)[2][2][4][2], Unit& cur) {
    int tid = threadIdx.x; asm volatile("" : "+v"(tid));
    const int wid = __builtin_amdgcn_readfirstlane(tid >> 6), lane = tid & 63, wr = wid >> 2, wc = wid & 3, fr = lane & 15, fq = lane >> 4;
    const int K = g.K, nt = K / BK;
    unsigned voffA[2], voffB[2];
#pragma unroll
    for (int i = 0; i < 2; ++i) { int R, C; stage_rc(tid * 16 + i * 8192, R, C); voffA[i] = (unsigned)(R * g.lda + C) * 2u; voffB[i] = (unsigned)(R * g.ldb + C) * 2u; }
    const size_t kstep = (size_t)(BK * 2);
    const size_t hstepA = (size_t)HALF * g.lda * 2, hstepB = (size_t)HALF * g.ldb * 2;
    const unsigned ldsw = (unsigned)wid * 1024u;
    const int aoff = lds_byte(wr * 64 + fr, fq * 8), boff = lds_byte(wc * 32 + fr, fq * 8);
#define PG8_SA(b, h) (((b) * 2 + (h)) * HTB)
#define PG8_SB(b, h) ((4 + (b) * 2 + (h)) * HTB)
#define PG8_STAGE(bufoff, gbase, voff) do { _Pragma("unroll") for (int _i = 0; _i < 2; ++_i) \
        __builtin_amdgcn_global_load_lds((const unsigned*)((const char*)(gbase) + (voff)[_i]), (LAS unsigned*)(lds + (bufoff) + ldsw + _i * 8192), 16, 0, 0); } while (0)
#define PG8_LDA(dst, b, h) do { _Pragma("unroll") for (int m = 0; m < 4; ++m) _Pragma("unroll") for (int k = 0; k < 2; ++k) dst[m][k] = *(const LAS bf16x8*)(lds + PG8_SA(b, h) + aoff + m * 2048 + k * 1024); } while (0)
#define PG8_LDB(dst, b, h) do { _Pragma("unroll") for (int n = 0; n < 2; ++n) _Pragma("unroll") for (int k = 0; k < 2; ++k) dst[n][k] = *(const LAS bf16x8*)(lds + PG8_SB(b, h) + boff + n * 2048 + k * 1024); } while (0)
#define PG8_MMA(ai, bj, At, Bt) do { __builtin_amdgcn_s_setprio(1); _Pragma("unroll") for (int m = 0; m < 4; ++m) _Pragma("unroll") for (int n = 0; n < 2; ++n) _Pragma("unroll") for (int k = 0; k < 2; ++k) \
        acc[ai][bj][m][n] = __builtin_amdgcn_mfma_f32_16x16x32_bf16(Bt[n][k], At[m][k], acc[ai][bj][m][n], 0, 0, 0); __builtin_amdgcn_s_setprio(0); } while (0)
#define PG8_WAIT_V(n) asm volatile("s_waitcnt vmcnt(" #n ")" ::: "memory")
#define PG8_WAIT_L(n) asm volatile("s_waitcnt lgkmcnt(" #n ")" ::: "memory")
#define PG8_BAR __builtin_amdgcn_s_barrier()
#define PG8_SCHED __builtin_amdgcn_sched_barrier(0)
    Unit nxt; int ui = 0;
    if (!S.next(0, cur)) return;
#pragma unroll
    for (int a = 0; a < 2; ++a)
#pragma unroll
        for (int b = 0; b < 2; ++b)
#pragma unroll
            for (int m = 0; m < 4; ++m)
#pragma unroll
                for (int n = 0; n < 2; ++n) acc[a][b][m][n] = (f32x4){0.f, 0.f, 0.f, 0.f};
    bf16x8 At[4][2], B0[2][2], B1[2][2];
    const char* cA = (const char*)g.aptr(cur); const char* cB = (const char*)g.bptr(cur);
    PG8_STAGE(PG8_SB(0, 0), cB, voffB); PG8_STAGE(PG8_SB(0, 1), cB + hstepB, voffB); PG8_STAGE(PG8_SA(0, 0), cA, voffA); PG8_STAGE(PG8_SA(0, 1), cA + hstepA, voffA);
    if (wr == 1) PG8_BAR;
    PG8_WAIT_V(2); PG8_BAR;
    PG8_STAGE(PG8_SB(1, 0), cB + kstep, voffB); PG8_STAGE(PG8_SA(1, 0), cA + kstep, voffA); PG8_STAGE(PG8_SB(1, 1), cB + hstepB + kstep, voffB);
    PG8_WAIT_V(6); PG8_BAR;
    for (;;) {
        const bool has_next = S.next(ui + 1, nxt);
        const char* nA = has_next ? (const char*)g.aptr(nxt) : cA; const char* nB = has_next ? (const char*)g.bptr(nxt) : cB;
        for (int t = 0; t < nt; t += 2) {
            const bool last = (t == nt - 2);
            const char* a1 = cA + (size_t)(t + 1) * kstep;
            const char* a2 = last ? nA : cA + (size_t)(t + 2) * kstep; const char* b2 = last ? nB : cB + (size_t)(t + 2) * kstep;
            const char* a3 = a2 + kstep; const char* b3 = b2 + kstep;
            PG8_LDB(B0, 0, 0); PG8_LDB(B1, 0, 1); PG8_SCHED; PG8_LDA(At, 0, 0); PG8_STAGE(PG8_SA(1, 1), a1 + hstepA, voffA);
            PG8_WAIT_V(8); PG8_WAIT_L(0); PG8_BAR; PG8_MMA(0, 0, At, B0); PG8_MMA(0, 1, At, B1); PG8_BAR; PG8_SCHED;
            PG8_LDA(At, 0, 1); PG8_STAGE(PG8_SB(0, 0), b2, voffB); PG8_STAGE(PG8_SB(0, 1), b2 + hstepB, voffB); PG8_STAGE(PG8_SA(0, 0), a2, voffA);
            PG8_WAIT_V(8); PG8_WAIT_L(0); PG8_BAR; PG8_MMA(1, 0, At, B0); PG8_MMA(1, 1, At, B1); PG8_BAR; PG8_SCHED;
            PG8_LDB(B0, 1, 0); PG8_LDB(B1, 1, 1); PG8_SCHED; PG8_LDA(At, 1, 0); PG8_STAGE(PG8_SA(0, 1), a2 + hstepA, voffA);
            PG8_WAIT_V(8); PG8_WAIT_L(0); PG8_BAR; PG8_MMA(0, 0, At, B0); PG8_MMA(0, 1, At, B1); PG8_BAR; PG8_SCHED;
            PG8_LDA(At, 1, 1); PG8_STAGE(PG8_SB(1, 0), b3, voffB); PG8_STAGE(PG8_SB(1, 1), b3 + hstepB, voffB); PG8_STAGE(PG8_SA(1, 0), a3, voffA);
            PG8_WAIT_V(8); PG8_WAIT_L(0); PG8_BAR; PG8_MMA(1, 0, At, B0); PG8_MMA(1, 1, At, B1); PG8_BAR; PG8_SCHED;
        }
        if (wr == 0) PG8_BAR;
        if constexpr (DEFER) {   }
        else if constexpr (Epi::TILE) E.tile(acc, cur, wr, wc, fr, fq);
        else {
            const int row0 = cur.pm * BM + wr * 64 + fr, col0 = cur.pn * BM + wc * 32 + 4 * fq;
#pragma unroll
            for (int ai = 0; ai < 2; ++ai)
#pragma unroll
                for (int m = 0; m < 4; ++m)
#pragma unroll
                    for (int bj = 0; bj < 2; ++bj)
#pragma unroll
                        for (int n = 0; n < 2; ++n) E.put(cur, row0 + ai * HALF + m * 16, col0 + bj * HALF + n * 16, acc[ai][bj][m][n]);
        }
        if (!has_next) break;
#pragma unroll
        for (int a = 0; a < 2; ++a)
#pragma unroll
            for (int b = 0; b < 2; ++b)
#pragma unroll
                for (int m = 0; m < 4; ++m)
#pragma unroll
                    for (int n = 0; n < 2; ++n) acc[a][b][m][n] = (f32x4){0.f, 0.f, 0.f, 0.f};
        cur = nxt; cA = nA; cB = nB; ++ui;
        if (wr == 1) PG8_BAR;
    }
    PG8_WAIT_V(0);
    PG8_BAR;
#undef PG8_SA
#undef PG8_SB
#undef PG8_STAGE
#undef PG8_LDA
#undef PG8_LDB
#undef PG8_MMA
#undef PG8_WAIT_V
#undef PG8_WAIT_L
#undef PG8_BAR
#undef PG8_SCHED
}
template <class Epi, class Sched>
__device__ __forceinline__ void gemm_fast(LAS unsigned char* lds, const GemmP g, const Sched& S, const Epi& E) {
    f32x4 acc[2][2][4][2]; Unit cur;
    gemm_fast_core<Epi, Sched, false>(lds, g, S, E, acc, cur);
}
struct EpiNone { static constexpr bool TILE = false; __device__ __forceinline__ void put(const Unit&, int, int, f32x4) const {} };
__device__ __forceinline__ void tile_rowsq_publish(const f32x4 (&v)[2][2][4][2], const Unit& u, LAS unsigned char* lds, float* slots) {
    int tid = threadIdx.x; asm volatile("" : "+v"(tid));
    const int wid = __builtin_amdgcn_readfirstlane(tid >> 6), lane = tid & 63, wr = wid >> 2, wc = wid & 3, fr = lane & 15, fq = lane >> 4;
    LAS float* red = (LAS float*)lds;
#pragma unroll
    for (int ai = 0; ai < 2; ++ai)
#pragma unroll
        for (int m = 0; m < 4; ++m) { float sq = 0.f;
#pragma unroll
            for (int bj = 0; bj < 2; ++bj)
#pragma unroll
                for (int n = 0; n < 2; ++n) { const f32x4 x = v[ai][bj][m][n]; sq += (x[0] * x[0] + x[1] * x[1]) + (x[2] * x[2] + x[3] * x[3]); }
            sq += __shfl_xor(sq, 16); sq += __shfl_xor(sq, 32);
            if (fq == 0) red[(ai * HALF + wr * 64 + m * 16 + fr) * 4 + wc] = sq; }
    __syncthreads();
    if (tid < 256) { const f32x4 r = *(const LAS f32x4*)(red + tid * 4); slots[(size_t)(u.pm * BM + tid) * 8 + u.pn] = (r[0] + r[1]) + (r[2] + r[3]); }
}
__device__ __forceinline__ float row_rstd(const float* slots, int row) {
    const unsigned long long* sp = (const unsigned long long*)(slots + (size_t)row * 8); float t = 0.f;
#pragma unroll
    for (int q = 0; q < 4; ++q) { const unsigned long long w = __hip_atomic_load(sp + q, __ATOMIC_RELAXED, __HIP_MEMORY_SCOPE_AGENT); t += __uint_as_float((unsigned)w) + __uint_as_float((unsigned)(w >> 32)); }
    return rsqrtf(t * (1.0f / DM) + EPS);
}

template <class Epi, class Sched>
__device__ __forceinline__ void gemm_run(LAS unsigned char* lds, const GemmP g, const Sched& S, const Epi& E) {
#if GEMM_FAST
    gemm_fast(lds, g, S, E);
#else
    gemm_naive(g, S, E);
#endif
}


__device__ __forceinline__ f32x4 mma16(bf16x8 afrag, bf16x8 bfrag, f32x4 acc) { return __builtin_amdgcn_mfma_f32_16x16x32_bf16(bfrag, afrag, acc, 0, 0, 0); }
constexpr int GLA_NCH = 36;
template <int CTRL> __device__ __forceinline__ float dppz(float v) { return __int_as_float(__builtin_amdgcn_update_dpp(0, __float_as_int(v), CTRL, 0xf, 0xf, true)); }
#define LBAR() do { asm volatile("s_waitcnt lgkmcnt(0)" ::: "memory"); __builtin_amdgcn_s_barrier(); asm volatile("" ::: "memory"); } while (0)
__device__ __forceinline__ void gla_prep(LAS unsigned char* lds, int ufirst, int ucount, const bf16_t* Qb, const bf16_t* Kb, const bf16_t* Vb, const bf16_t* LR,
                                         const float* wgf, const float* bgf, const float* wgb, const float* bgb,
                                         bf16_t* KS, bf16_t* QD, bf16_t* VT, float* DEC, bf16_t* Of, bf16_t* Ob) {
    int tid = threadIdx.x; asm volatile("" : "+v"(tid));
    const int lane = tid & 63, wave = __builtin_amdgcn_readfirstlane(tid >> 6), fr = lane & 15, fq = lane >> 4;
    LAS bf16_t* qd = (LAS bf16_t*)lds; LAS bf16_t* kd = qd + 64 * 136; LAS bf16_t* sc = kd + 64 * 136; LAS bf16_t* vT = sc + 64 * 72;
    LAS bf16_t* ksT = vT + 256 * 72;
#pragma unroll 1
    for (int ui = 0; ui < ucount; ++ui) {
        const int unit = ufirst + ui;
        const int bh = unit / (2 * GLA_NCH), rem = unit % (2 * GLA_NCH), dir = rem / GLA_NCH, cidx = rem % GLA_NCH, b = bh >> 2, h = bh & 3;
        const bool lat = cidx >= 4;
        const int row0 = lat ? b * SEQ + (cidx - 4) * 64 : M + b * CTX + cidx * 64;
        const int kidx = (bh * 2 + dir) * GLA_NCH + cidx, qidx = (bh * 2 + dir) * 32 + (cidx - 4);
        const float* wsrc = dir ? wgb : wgf; const float* bsrc = dir ? bgb : bgf;
        LBAR();
        if (lat || dir == 0) {
#pragma unroll
            for (int j = 0; j < 4; ++j) { const int idx = tid + 512 * j, sp = idx & 63, c8 = (idx >> 6) * 8; const bf16x8 v = *(const bf16x8*)(Vb + (size_t)(row0 + sp) * VW + h * DV + c8);
#pragma unroll
                for (int e = 0; e < 8; ++e) vT[(c8 + e) * 72 + sp] = (bf16_t)v[e]; }
        }
        bf16x8 afr[4], bfr;
#pragma unroll
        for (int pt = 0; pt < 4; ++pt) afr[pt] = *(const bf16x8*)(LR + (size_t)(row0 + 16 * pt + fr) * 256 + dir * 16 + (fq & 1) * 8);
        { const float* wp = wsrc + (size_t)((fq & 1) * 8) * QKW + h * DK + 16 * wave + fr;
#pragma unroll
          for (int e = 0; e < 8; ++e) { const float wv = wp[e * QKW]; const unsigned hi = f2bfhw(wv); const float res = wv - bf2f((unsigned short)hi); bfr[e] = (short)(fq < 2 ? hi : f2bfhw(res)); } }
        const f32x4 bias4 = *(const f32x4*)(bsrc + h * DK + 16 * wave + 4 * fq);
        f32x4 k4[4], q4[4];
#pragma unroll
        for (int pt = 0; pt < 4; ++pt) { const size_t o = (size_t)(row0 + 16 * pt + fr) * QKW + h * DK + 16 * wave + 4 * fq; k4[pt] = ld_bf4(Kb + o); q4[pt] = lat ? ld_bf4(Qb + o) : (f32x4){0.f, 0.f, 0.f, 0.f}; }
        f32x4 la[4];
#pragma unroll
        for (int pt = 0; pt < 4; ++pt) { const f32x4 z = mma16(afr[pt], bfr, bias4);
#pragma unroll
            for (int i = 0; i < 4; ++i) { float x = (fminf(z[i], 0.f) - __logf(1.0f + __expf(-fabsf(z[i])))) * (1.0f / 16.0f);
                if (!dir) { x += dppz<0x111>(x); x += dppz<0x112>(x); x += dppz<0x114>(x); x += dppz<0x118>(x); }
                else      { x += dppz<0x101>(x); x += dppz<0x102>(x); x += dppz<0x104>(x); x += dppz<0x108>(x); }
                la[pt][i] = x; } }
        f32x4 carry = (f32x4){0.f, 0.f, 0.f, 0.f};
        if (!dir) {
#pragma unroll
            for (int pt = 0; pt < 4; ++pt) { f32x4 t;
#pragma unroll
                for (int i = 0; i < 4; ++i) t[i] = __shfl(la[pt][i], (lane & 48) | 15);
                la[pt] += carry; carry += t; }
        } else {
#pragma unroll
            for (int pt = 3; pt >= 0; --pt) { f32x4 t;
#pragma unroll
                for (int i = 0; i < 4; ++i) t[i] = __shfl(la[pt][i], lane & 48);
                la[pt] += carry; carry += t; }
        }
        const f32x4 blast = carry;
#pragma unroll
        for (int pt = 0; pt < 4; ++pt) { const int p = 16 * pt + fr;
            f32x4 ks, qn, kn;
#pragma unroll
            for (int i = 0; i < 4; ++i) { const float bv = la[pt][i]; ks[i] = k4[pt][i] * __expf(blast[i] - bv); qn[i] = q4[pt][i] * __expf(bv); kn[i] = k4[pt][i] * __expf(-bv); }
            const unsigned k01 = pk2hw(ks[0], ks[1]), k23 = pk2hw(ks[2], ks[3]);
            LAS bf16_t* kt = ksT + (16 * wave + 4 * fq) * 72 + p;
            kt[0] = (bf16_t)(k01 & 0xffffu); kt[72] = (bf16_t)(k01 >> 16); kt[144] = (bf16_t)(k23 & 0xffffu); kt[216] = (bf16_t)(k23 >> 16);
            if (lat) { u32x2 w; w.x = pk2hw(qn[0], qn[1]); w.y = pk2hw(qn[2], qn[3]); *(LAS u32x2*)(qd + p * 136 + 16 * wave + 4 * fq) = w;
                       w.x = pk2hw(kn[0], kn[1]); w.y = pk2hw(kn[2], kn[3]); *(LAS u32x2*)(kd + p * 136 + 16 * wave + 4 * fq) = w; } }
        if (fr == 0) { f32x4 dv; dv[0] = __expf(blast[0]); dv[1] = __expf(blast[1]); dv[2] = __expf(blast[2]); dv[3] = __expf(blast[3]); *(f32x4*)(DEC + kidx * 128 + 16 * wave + 4 * fq) = dv; }
        LBAR();
#pragma unroll
        for (int j = 0; j < 2; ++j) { const int idx = tid + 512 * j, dd = idx >> 3, part = idx & 7;
            *(u32x4*)(KS + (size_t)kidx * 8192 + ((((dd >> 4) * 2 + (part >> 2)) * 64 + (part & 3) * 16 + (dd & 15)) << 3)) = *(const LAS u32x4*)(ksT + dd * 72 + part * 8); }
        if (dir == 0) {
#pragma unroll
            for (int j = 0; j < 4; ++j) { const int idx = tid + 512 * j, v = idx >> 3, part = idx & 7;
                *(u32x4*)(VT + (size_t)(bh * GLA_NCH + cidx) * 16384 + ((((v >> 4) * 2 + (part >> 2)) * 64 + (part & 3) * 16 + (v & 15)) << 3)) = *(const LAS u32x4*)(vT + v * 72 + part * 8); }
        }
        if (lat) {
#pragma unroll
            for (int j = 0; j < 2; ++j) { const int idx = tid + 512 * j, pr = idx >> 4, part = idx & 15;
                *(u32x4*)(QD + (size_t)qidx * 8192 + ((((pr >> 4) * 4 + (part >> 2)) * 64 + (part & 3) * 16 + (pr & 15)) << 3)) = *(const LAS u32x4*)(qd + pr * 136 + part * 8); }
            { const int ct = wave >> 1; f32x4 acc[2] = {(f32x4){0.f, 0.f, 0.f, 0.f}, (f32x4){0.f, 0.f, 0.f, 0.f}};
#pragma unroll
                for (int k0 = 0; k0 < 4; ++k0) { const bf16x8 af = *(const LAS bf16x8*)(qd + (16 * ct + fr) * 136 + k0 * 32 + fq * 8);
#pragma unroll
                    for (int j = 0; j < 2; ++j) { const int st = (wave & 1) * 2 + j; const bf16x8 bf = *(const LAS bf16x8*)(kd + (16 * st + fr) * 136 + k0 * 32 + fq * 8); acc[j] = mma16(af, bf, acc[j]); } }
#pragma unroll
                for (int j = 0; j < 2; ++j) { const int st = (wave & 1) * 2 + j, c = 16 * ct + fr; f32x4 v = acc[j];
#pragma unroll
                    for (int i = 0; i < 4; ++i) { const int sp = 16 * st + 4 * fq + i; const bool keep = dir ? (sp >= c) : (sp <= c); v[i] = keep ? v[i] : 0.f; }
                    u32x2 w; w.x = pk2hw(v[0], v[1]); w.y = pk2hw(v[2], v[3]); *(LAS u32x2*)(sc + c * 72 + 16 * st + 4 * fq) = w; }
            }
            LBAR();
            { f32x4 acc[4][2];
#pragma unroll
                for (int ct = 0; ct < 4; ++ct) { acc[ct][0] = (f32x4){0.f, 0.f, 0.f, 0.f}; acc[ct][1] = (f32x4){0.f, 0.f, 0.f, 0.f}; }
#pragma unroll
                for (int k0 = 0; k0 < 2; ++k0) { bf16x8 bf[2];
#pragma unroll
                    for (int j = 0; j < 2; ++j) bf[j] = *(const LAS bf16x8*)(vT + (16 * (2 * wave + j) + fr) * 72 + k0 * 32 + fq * 8);
#pragma unroll
                    for (int ct = 0; ct < 4; ++ct) { const bf16x8 af = *(const LAS bf16x8*)(sc + (16 * ct + fr) * 72 + k0 * 32 + fq * 8);
                        acc[ct][0] = mma16(af, bf[0], acc[ct][0]); acc[ct][1] = mma16(af, bf[1], acc[ct][1]); } }
                bf16_t* O = dir ? Ob : Of;
#pragma unroll
                for (int ct = 0; ct < 4; ++ct)
#pragma unroll
                    for (int j = 0; j < 2; ++j) st_bf4(O + (((((((size_t)(b * 32 + cidx - 4) * 4 + h) * 8 + wave) * 4 + ct) * 2 + j) * 64 + lane) << 2), acc[ct][j]);
            }
        }
    }
    LBAR();
}
__device__ __forceinline__ void gla_scan(LAS unsigned char* lds, int bx, int G, const bf16_t* KS, const bf16_t* QD, const bf16_t* VT, const float* DEC, bf16_t* Of, bf16_t* Ob) {
    int tid = threadIdx.x; asm volatile("" : "+v"(tid));
    const int lane = tid & 63, wave = __builtin_amdgcn_readfirstlane(tid >> 6), fr = lane & 15, fq = lane >> 4;
    LAS bf16_t* ST = (LAS bf16_t*)lds;
    for (int unit = bx; unit < 256; unit += G) {
        const int vs = unit & 7, dir = (unit >> 3) & 1, bh = unit >> 4, b = bh >> 2, h = bh & 3;
        bf16_t* O = dir ? Ob : Of;
        f32x4 S0 = (f32x4){0.f, 0.f, 0.f, 0.f}, S1 = S0;
        const bf16x8 z8 = (bf16x8){0, 0, 0, 0, 0, 0, 0, 0};
#define GLB_DECL(P) bf16x8 P##ks0 = z8, P##ks1 = z8, P##v00 = z8, P##v01 = z8, P##v10 = z8, P##v11 = z8, P##q0 = z8, P##q1 = z8, P##q2 = z8, P##q3 = z8; float P##dec = 0.f; u32x2 P##oin = (u32x2){0u, 0u}; int P##row0 = 0;
        GLB_DECL(a_) GLB_DECL(b_) GLB_DECL(c_)
#define GLB_LOAD(step_, P) do { const int st_ = (step_); if (st_ < GLA_NCH) { const int cidx_ = st_ < 4 ? (dir ? 3 - st_ : st_) : (dir ? 39 - st_ : st_); \
        const int kidx_ = (bh * 2 + dir) * GLA_NCH + cidx_; const bf16_t* ksp_ = KS + (size_t)kidx_ * 8192 + ((wave * 2 * 64 + lane) << 3); \
        P##ks0 = *(const bf16x8*)ksp_; P##ks1 = *(const bf16x8*)(ksp_ + 512); \
        const bf16_t* vtp_ = VT + (size_t)(bh * GLA_NCH + cidx_) * 16384 + ((vs * 4 * 64 + lane) << 3); \
        P##v00 = *(const bf16x8*)vtp_; P##v01 = *(const bf16x8*)(vtp_ + 512); P##v10 = *(const bf16x8*)(vtp_ + 1024); P##v11 = *(const bf16x8*)(vtp_ + 1536); \
        P##dec = DEC[kidx_ * 128 + 16 * wave + fr]; \
        if (cidx_ >= 4) { const bf16_t* qp_ = QD + (size_t)((bh * 2 + dir) * 32 + cidx_ - 4) * 8192 + (((wave >> 1) * 4 * 64 + lane) << 3); \
            P##q0 = *(const bf16x8*)qp_; P##q1 = *(const bf16x8*)(qp_ + 512); P##q2 = *(const bf16x8*)(qp_ + 1024); P##q3 = *(const bf16x8*)(qp_ + 1536); \
            P##row0 = cidx_ - 4; \
            P##oin = *(const u32x2*)(O + (((((((size_t)(b * 32 + P##row0) * 4 + h) * 8 + vs) * 4 + (wave >> 1)) * 2 + (wave & 1)) * 64 + lane) << 2)); } } } while (0)
#define GLB_STEP(step_, P) do { const int sp_ = (step_); \
        if (sp_ >= 4) { const LAS bf16_t* stb = ST + ((sp_ - 1) & 1) * (32 * 136) + (16 * (wave & 1) + fr) * 136 + fq * 8; \
            f32x4 acc = (f32x4){0.f, 0.f, 0.f, 0.f}; \
            acc = mma16(P##q0, *(const LAS bf16x8*)(stb), acc); acc = mma16(P##q1, *(const LAS bf16x8*)(stb + 32), acc); \
            acc = mma16(P##q2, *(const LAS bf16x8*)(stb + 64), acc); acc = mma16(P##q3, *(const LAS bf16x8*)(stb + 96), acc); \
            const f32x4 oi_ = (f32x4){__uint_as_float(P##oin.x << 16), __uint_as_float(P##oin.x & 0xffff0000u), __uint_as_float(P##oin.y << 16), __uint_as_float(P##oin.y & 0xffff0000u)}; \
            st_bf4(O + (((((((size_t)(b * 32 + P##row0) * 4 + h) * 8 + vs) * 4 + (wave >> 1)) * 2 + (wave & 1)) * 64 + lane) << 2), oi_ + acc); } \
        S0 = S0 * P##dec; S1 = S1 * P##dec; \
        S0 = mma16(P##ks0, P##v00, S0); S0 = mma16(P##ks1, P##v01, S0); S1 = mma16(P##ks0, P##v10, S1); S1 = mma16(P##ks1, P##v11, S1); \
        { LAS bf16_t* stw = ST + (sp_ & 1) * (32 * 136) + 16 * wave + fr; \
          _Pragma("unroll") for (int i = 0; i < 4; ++i) { stw[(4 * fq + i) * 136] = (bf16_t)f2bfhw(S0[i]); stw[(16 + 4 * fq + i) * 136] = (bf16_t)f2bfhw(S1[i]); } } \
        asm volatile("s_waitcnt lgkmcnt(0)" ::: "memory"); __builtin_amdgcn_s_barrier(); asm volatile("" ::: "memory"); } while (0)
        __syncthreads();
        GLB_LOAD(0, a_); GLB_LOAD(1, b_);
        for (int step = 0; step < GLA_NCH; step += 3) {
            GLB_LOAD(step + 2, c_); GLB_STEP(step, a_);
            GLB_LOAD(step + 3, a_); GLB_STEP(step + 1, b_);
            GLB_LOAD(step + 4, b_); GLB_STEP(step + 2, c_);
        }
#undef GLB_STEP
#undef GLB_DECL
#undef GLB_LOAD
    }
    __syncthreads();
}

#define XB_TMO      128
#define XB_XCNT(j)  (256  + 64 * (j))
#define XB_XSUB(j)  (1280 + 64 * (j))
#define XB_XGEN(j)  (2304 + 64 * (j))
#define XB_TOP      3328
#define XB_TOPGEN   3392
#define XCD_BAR_WORDS 3456
#define XB_SPIN_CAP (1u << 18)

__device__ __forceinline__ unsigned xb_ld(unsigned* p)              { return __hip_atomic_load(p, __ATOMIC_RELAXED, __HIP_MEMORY_SCOPE_AGENT); }
__device__ __forceinline__ unsigned xb_add(unsigned* p, unsigned v) { return __hip_atomic_fetch_add(p, v, __ATOMIC_RELAXED, __HIP_MEMORY_SCOPE_AGENT); }
__device__ __forceinline__ unsigned xb_xcc_id() { return (unsigned)__builtin_amdgcn_s_getreg((3 << 11) | 20) & 0xFu; }
#define XB_SPIN(cond, bar) do { unsigned _sp = 0; while (cond) { __builtin_amdgcn_s_sleep(1); \
    if ((++_sp & 255u) == 0u) { if (xb_ld(&(bar)[XB_TMO])) break; if (_sp > XB_SPIN_CAP) { atomicAdd(&(bar)[XB_TMO], 1u); break; } } } } while (0)

struct XcdBarrier {
    unsigned* bar; unsigned x;
    volatile LAS unsigned* st;
};

__device__ __forceinline__ XcdBarrier xcd_barrier_post(unsigned* bar, volatile LAS unsigned* st) {
    XcdBarrier b; b.bar = bar; b.x = xb_xcc_id(); b.st = st;
    if (threadIdx.x == 0) (void)xb_add(&bar[XB_XCNT(b.x)], 1u);
    return b;
}
__device__ __forceinline__ void xcd_barrier_complete(unsigned* bar, unsigned x, unsigned& nloc, unsigned& nx) {
    const unsigned G = gridDim.x * gridDim.y * gridDim.z;
    unsigned sum, cnt, mine, sp = 0u;
    for (;;) {
        sum = 0u; cnt = 0u; mine = 0u;
#pragma unroll
        for (unsigned j = 0; j < 16; ++j) { const unsigned c = xb_ld(&bar[XB_XCNT(j)]); sum += c; cnt += (c > 0u) ? 1u : 0u; mine = (j == x) ? c : mine; }
        if (sum == G) break;
        __builtin_amdgcn_s_sleep(1);
        if ((++sp & 255u) == 0u) { if (xb_ld(&bar[XB_TMO])) break; if (sp > XB_SPIN_CAP) { atomicAdd(&bar[XB_TMO], 1u); break; } }
    }
    nloc = mine > 0u ? mine : 1u; nx = cnt > 0u ? cnt : 1u;
}

__device__ __forceinline__ void xcd_barrier(const XcdBarrier& b) {
    asm volatile("s_waitcnt vmcnt(0)" ::: "memory");
    __syncthreads();
    if (threadIdx.x == 0) {
        unsigned* bar = b.bar;
        __builtin_amdgcn_s_waitcnt(0);
        unsigned nloc = b.st[0], nx = b.st[1];
        if (nloc == 0u) { xcd_barrier_complete(bar, b.x, nloc, nx); b.st[0] = nloc; b.st[1] = nx; }
        const unsigned old = xb_add(&bar[XB_XSUB(b.x)], 1u);
        const unsigned gen = old / nloc;
        if (old + 1u == (gen + 1u) * nloc) {
            __builtin_amdgcn_fence(__ATOMIC_RELEASE, "agent");
            asm volatile("s_waitcnt vmcnt(0)" ::: "memory");
            const unsigned og = xb_add(&bar[XB_TOP], 1u);
            const unsigned tg = og / nx;
            if (og + 1u == (tg + 1u) * nx) xb_add(&bar[XB_TOPGEN], 1u);
            else XB_SPIN(xb_ld(&bar[XB_TOPGEN]) == tg, bar);
            __builtin_amdgcn_fence(__ATOMIC_ACQUIRE, "agent");
            xb_add(&bar[XB_XGEN(b.x)], 1u);
            asm volatile("s_waitcnt vmcnt(0)" ::: "memory");
        } else {
            XB_SPIN(xb_ld(&bar[XB_XGEN(b.x)]) == gen, bar);
            __builtin_amdgcn_fence(__ATOMIC_ACQUIRE, "agent");
            asm volatile("s_waitcnt vmcnt(0)" ::: "memory");
        }
    }
    __syncthreads();
}
__device__ __forceinline__ void xcd_barrier_light(const XcdBarrier& b) {
    asm volatile("s_waitcnt vmcnt(0)" ::: "memory");
    __syncthreads();
    if (threadIdx.x == 0) {
        unsigned* bar = b.bar;
        __builtin_amdgcn_s_waitcnt(0);
        unsigned nloc = b.st[0], nx = b.st[1];
        if (nloc == 0u) { xcd_barrier_complete(bar, b.x, nloc, nx); b.st[0] = nloc; b.st[1] = nx; }
        const unsigned old = xb_add(&bar[XB_XSUB(b.x)], 1u);
        const unsigned gen = old / nloc;
        if (old + 1u == (gen + 1u) * nloc) {
            asm volatile("s_waitcnt vmcnt(0)" ::: "memory");
            const unsigned og = xb_add(&bar[XB_TOP], 1u);
            const unsigned tg = og / nx;
            if (og + 1u == (tg + 1u) * nx) xb_add(&bar[XB_TOPGEN], 1u);
            else XB_SPIN(xb_ld(&bar[XB_TOPGEN]) == tg, bar);
            xb_add(&bar[XB_XGEN(b.x)], 1u);
            asm volatile("s_waitcnt vmcnt(0)" ::: "memory");
        } else {
            XB_SPIN(xb_ld(&bar[XB_XGEN(b.x)]) == gen, bar);
            asm volatile("s_waitcnt vmcnt(0)" ::: "memory");
        }
    }
    __syncthreads();
}

__device__ __forceinline__ void transpose_item(const float* W, int K, int N, bf16_t* WT, int drow0, LAS float* scr, int k0, int n0, int lane) {
#pragma unroll 8
    for (int i = 0; i < 32; ++i) { const int kk = 2 * i + (lane >> 5); scr[kk * 33 + (lane & 31)] = W[(size_t)(k0 + kk) * N + n0 + (lane & 31)]; }
    asm volatile("s_waitcnt lgkmcnt(0)" ::: "memory");
    const int c = lane & 7;
#pragma unroll
    for (int j = 0; j < 4; ++j) { const int n = (lane >> 3) + 8 * j; const LAS float* s = scr + (8 * c) * 33 + n;
        u32x4 o; o.x = pk2(s[0 * 33], s[1 * 33]); o.y = pk2(s[2 * 33], s[3 * 33]); o.z = pk2(s[4 * 33], s[5 * 33]); o.w = pk2(s[6 * 33], s[7 * 33]);
        *(u32x4*)(WT + (size_t)(drow0 + n) * K + k0 + 8 * c) = o; }
    asm volatile("s_waitcnt lgkmcnt(0)" ::: "memory");
}

template <int MODOFF, bool STORE>
__device__ __forceinline__ void epi_rows_part1(LAS unsigned char* lds, const f32x4 (&acc)[2][2][4][2], const Unit& u, const float* base, const float* mod, float* outp, float* slots, f32x4 (&xr)[2][16]) {
    int tid = threadIdx.x; asm volatile("" : "+v"(tid));
    const int wid = __builtin_amdgcn_readfirstlane(tid >> 6), lane = tid & 63, wr = wid >> 2, wc = wid & 3, fr = lane & 15, fq = lane >> 4;
    LAS float* T = (LAS float*)lds;
    const int colg = u.pn * BM + 4 * lane;
    const f32x4 gt = *(const f32x4*)(mod + ((u.pm * BM) >> 11) * MODW + MODOFF * DM + colg);
#pragma unroll
    for (int ai = 0; ai < 2; ++ai) {
        if (ai) LBAR();
#pragma unroll
        for (int m = 0; m < 4; ++m)
#pragma unroll
            for (int bj = 0; bj < 2; ++bj)
#pragma unroll
                for (int n = 0; n < 2; ++n) { const int rl = wr * 64 + m * 16 + fr, c4 = (bj * HALF + wc * 32 + n * 16 + 4 * fq) >> 2;
                    *(LAS f32x4*)(T + rl * 256 + ((c4 ^ (rl & 15)) << 2)) = acc[ai][bj][m][n]; }
        LBAR();
#pragma unroll
        for (int j = 0; j < 16; ++j) { const int rl = wid * 16 + j, row = u.pm * BM + ai * HALF + rl; const size_t o = (size_t)row * DM + colg;
            const f32x4 v = *(const LAS f32x4*)(T + rl * 256 + ((lane ^ j) << 2));
            const f32x4 x1 = *(const f32x4*)(base + o) + gt * v; xr[ai][j] = x1; if (STORE) *(f32x4*)(outp + o) = x1;
            const float sq = wave_sum((x1[0] * x1[0] + x1[1] * x1[1]) + (x1[2] * x1[2] + x1[3] * x1[3]));
            if (lane == 0) __hip_atomic_store((unsigned*)slots + (size_t)row * 8 + u.pn, __float_as_uint(sq), __ATOMIC_RELAXED, __HIP_MEMORY_SCOPE_AGENT); }
    }
}

struct Args { const float* in[N_IN]; float* out; unsigned char* ws; };

__global__ void __launch_bounds__(NTHR, 2) fwd_kernel(Args a) {
    extern __shared__ __attribute__((aligned(16))) unsigned char lds_raw[];
    LAS unsigned char* lds = (LAS unsigned char*)lds_raw;
    cg::grid_group grid = cg::this_grid();
    const int G = gridDim.x, bx = blockIdx.x, NGW = G * 8, NT = G * NTHR;
    if (threadIdx.x < 64) ((LAS unsigned*)(lds + 131072))[threadIdx.x] = 0u;
    if (bx == 0) for (int i = threadIdx.x; i < XCD_BAR_WORDS; i += NTHR) __hip_atomic_store((unsigned*)(a.ws + 16384) + i, 0u, __ATOMIC_RELAXED, __HIP_MEMORY_SCOPE_AGENT);
    __syncthreads();
    grid.sync();
    const XcdBarrier xbar = xcd_barrier_post((unsigned*)(a.ws + 16384), (volatile LAS unsigned*)(lds + 131072 + 32));
#define GRID_BAR() xcd_barrier(xbar)
#define PHASE_IDS int tid = threadIdx.x; asm volatile("" : "+v"(tid)); const int lane = tid & 63, wave = __builtin_amdgcn_readfirstlane(tid >> 6), gw = bx * 8 + wave, gtid = bx * NTHR + tid; (void)lane; (void)gw; (void)gtid;
    unsigned char* ws = a.ws;
    float* mod = (float*)(ws + OFF_MOD);
    bf16_t* WinT = (bf16_t*)(ws + OFF_WIN); bf16_t* WglaT = (bf16_t*)(ws + OFF_WGLA); bf16_t* WfnT = (bf16_t*)(ws + OFF_WFN); bf16_t* WoT = (bf16_t*)(ws + OFF_WO);
    bf16_t* WupT = (bf16_t*)(ws + OFF_WUP); bf16_t* WdT = (bf16_t*)(ws + OFF_WD); bf16_t* DT = (bf16_t*)(ws + OFF_DT); bf16_t* CS = (bf16_t*)(ws + OFF_CS);
    bf16_t* H1 = (bf16_t*)(ws + OFF_A); bf16_t* XT = H1; bf16_t* Y = H1; bf16_t* H2 = H1;
    bf16_t* Qb = (bf16_t*)(ws + OFF_Q); bf16_t* Kb = (bf16_t*)(ws + OFF_K); bf16_t* Vb = (bf16_t*)(ws + OFF_V); bf16_t* Rb = (bf16_t*)(ws + OFF_R);
    bf16_t* Fb = (bf16_t*)(ws + OFF_F); bf16_t* GA = (bf16_t*)(ws + OFF_GA); bf16_t* GB = (bf16_t*)(ws + OFF_GB); bf16_t* LR = (bf16_t*)(ws + OFF_LR);
    bf16_t* Ff = (bf16_t*)(ws + OFF_FF); bf16_t* Of = (bf16_t*)(ws + OFF_OF); bf16_t* Ob = (bf16_t*)(ws + OFF_OB);
    bf16_t* AG = Qb; bf16_t* U = (bf16_t*)(ws + OFF_U); bf16_t* ACT = (bf16_t*)(ws + OFF_ACT);
    float* out = a.out;

    {
        PHASE_IDS
        LAS float* scr = (LAS float*)(lds + wave * 16384);
        constexpr int IT_IN = 32 * 257, IT_GLA = 16 * 64, IT_FN = 16 * 64, IT_OUT = 32 * 64;
        (void)IT_GLA; (void)IT_FN; (void)IT_OUT;
        for (int it = gw; it < IT_IN; it += NGW) {
            const int r = it, kb = r / 257, nb = r % 257, n0 = nb * 32; const int d0 = n0 < 3072 ? n0 : (n0 == 3072 ? 8192 : n0 - 32);
            transpose_item(a.in[I_WIN], DM, INW, WinT, d0, scr, kb * 64, n0, lane);
        }
        for (int i = gtid; i < 224 * 256; i += NT) ((u32x4*)(WinT + (size_t)8224 * DM))[i] = (u32x4){0u, 0u, 0u, 0u};
        for (int gi = gtid; gi < 2048 * 512; gi += NT) {
            const int k1 = gi >> 9, j0 = (gi & 511) * 8; float v[8];
#pragma unroll
            for (int e = 0; e < 8; ++e) { const int j = j0 + e; const int ph = (k1 * (j & 2047)) & 2047; const float x = (float)ph * (1.0f / 1024.0f); v[e] = j < 2048 ? cospif(x) : -sinpif(x); }
            u32x4 o; o.x = pk2(v[0], v[1]); o.y = pk2(v[2], v[3]); o.z = pk2(v[4], v[5]); o.w = pk2(v[6], v[7]);
            *(u32x4*)(DT + (size_t)k1 * 4096 + j0) = o;
        }
        for (int gi = gtid; gi < 512 * 32; gi += NT) {
            const int m = gi >> 5, c0 = (gi & 31) * 8; float v[8];
#pragma unroll
            for (int e = 0; e < 8; ++e) { const int ph = ((m & 255) * (c0 + e)) & 255; const float x = (float)ph * (1.0f / 128.0f); v[e] = (m < 256 ? cospif(x) : sinpif(x)) * 0.0625f; }
            u32x4 o; o.x = pk2(v[0], v[1]); o.y = pk2(v[2], v[3]); o.z = pk2(v[4], v[5]); o.w = pk2(v[6], v[7]);
            *(u32x4*)(CS + (size_t)m * 256 + c0) = o;
        }
    }
    {
        PHASE_IDS
        LAS float* sl = (LAS float*)lds;
        LAS float* red = sl + 5 * DM;
        __syncthreads();
        for (int i = tid; i < 5 * DM; i += NTHR) { const float c = i < 4 * DM ? a.in[I_C][i] : a.in[I_CCTX][i - 4 * DM]; sl[i] = c * sigmoidf_(c); }
        __syncthreads();
        for (int cb = bx; cb < 256; cb += G) {
            const int col = cb * 48 + (lane < 48 ? lane : 47);
            float acc[5] = {0.f, 0.f, 0.f, 0.f, 0.f};
            const float* wp = a.in[I_WADA] + (size_t)(wave * 256) * MODW + col;
#pragma unroll 16
            for (int kk = 0; kk < 256; ++kk) {
                const float w = wp[(size_t)kk * MODW];
#pragma unroll
                for (int r = 0; r < 5; ++r) acc[r] += w * sl[r * DM + wave * 256 + kk];
            }
            if (lane < 48) {
#pragma unroll
                for (int r = 0; r < 5; ++r) red[(wave * 5 + r) * 48 + lane] = acc[r];
            }
            __syncthreads();
            if (tid < 240) { const int r = tid / 48, c = tid % 48; float s = a.in[I_BADA][cb * 48 + c];
#pragma unroll
                for (int w = 0; w < 8; ++w) s += red[(w * 5 + r) * 48 + c];
                mod[r * MODW + cb * 48 + c] = s; }
            __syncthreads();
        }
    }
    GRID_BAR();

    { PHASE_IDS
    for (int m = gw; m < MT; m += NGW) {
        const float* src = m < M ? a.in[I_X] + (size_t)m * DM : a.in[I_CTX] + (size_t)(m - M) * DM;
        const float* md = mod + (m < M ? (m >> 11) : 4) * MODW;
        f32x4 v[8]; float ss = 0.f;
#pragma unroll
        for (int j = 0; j < 8; ++j) { v[j] = *(const f32x4*)(src + j * 256 + lane * 4); ss += (v[j][0] * v[j][0] + v[j][1] * v[j][1]) + (v[j][2] * v[j][2] + v[j][3] * v[j][3]); }
        const float rstd = rsqrtf(wave_sum(ss) * (1.0f / DM) + EPS);
#pragma unroll
        for (int j = 0; j < 8; ++j) { const int c = j * 256 + lane * 4;
            const f32x4 g = *(const f32x4*)(a.in[I_G1] + c), sh = *(const f32x4*)(md + c), sc = *(const f32x4*)(md + DM + c);
            st_bf4(H1 + (size_t)m * DM + c, (v[j] * rstd * g) * (sc + 1.0f) + sh); }
    } }
    GRID_BAR();

    {
        GemmP g{H1, WinT, DM, DM, DM, 0, 0}; SchedProj S; S.g = SchedGrid{32, 33, 32, G, bx};
        EpiProj E{Qb, Kb, Vb, Rb, Fb, GA, GB, LR};
        gemm_run(lds, g, S, E);
    }
    {
        constexpr int LASTR = 32 * 33 + 28 - 1024;
        const int first = (G == 256) ? LASTR : 0;
        if (bx >= first) {
            PHASE_IDS
            LAS float* scr = (LAS float*)(lds + wave * 16384);
            constexpr int IT_UP = 32 * 352, IT_DN = 88 * 64;
            const int gw2 = (bx - first) * 8 + wave, NGW2 = (G - first) * 8;
            constexpr int IT_GLA = 16 * 64, IT_FN = 16 * 64, IT_OUT = 32 * 64;
            for (int it = gw2; it < IT_UP + IT_GLA + IT_FN + IT_OUT; it += NGW2) {
                int r = it;
                if (r >= IT_UP) { r -= IT_UP;
                    if (r < IT_GLA) { transpose_item(a.in[I_WGLA], VW, DM, WglaT, (r % 64) * 32, scr, (r / 64) * 64, (r % 64) * 32, lane); continue; } r -= IT_GLA;
                    if (r < IT_FN) { transpose_item(a.in[I_WFN], FNW, DM, WfnT, (r % 64) * 32, scr, (r / 64) * 64, (r % 64) * 32, lane); continue; } r -= IT_FN;
                    transpose_item(a.in[I_WOUT], DM, DM, WoT, (r % 64) * 32, scr, (r / 64) * 64, (r % 64) * 32, lane); continue; }
                if (r < IT_UP) { const int n0 = (r % 352) * 32, j = n0 < FF ? n0 : n0 - FF; transpose_item(a.in[I_WUP], DM, F2, WupT, (j >> 7) * 256 + (n0 < FF ? 0 : 128) + (j & 127), scr, (r / 352) * 64, n0, lane); continue; } r -= IT_UP;
                transpose_item(a.in[I_WDN], FF, DM, WdT, (r % 64) * 32, scr, (r / 64) * 64, (r % 64) * 32, lane);
            }
        }
    }
    GRID_BAR();

    {
        GemmP g{CS, Fb, 256, FNW, 256, (long)SEQ * FNW, 256}; SchedGrid S{32, 8, 2, G, bx};
        EpiFn1 E{XT};
        gemm_run(lds, g, S, E);
    }
    GRID_BAR();
    bf16_t* KS = (bf16_t*)out; bf16_t* QD = (bf16_t*)((unsigned char*)out + 18 * MiB); bf16_t* VT = (bf16_t*)((unsigned char*)out + 34 * MiB); float* DEC = (float*)((unsigned char*)out + 52 * MiB);
    if (((bx >> 3) & 3) == 0) {
        const int fj = (bx >> 5) * 8 + (bx & 7);
        { GemmP g{DT, XT, 4096, 4096, 4096, (long)4 * 256 * 4096, (long)256 * 4096}; SchedGrid S{64, 1, 4, 64, fj};
          EpiFn2S E{Ff, 0.02209708691207961f};
          gemm_fast(lds, g, S, E); }
    } else {
        const int gj = (bx & 7) * 24 + (bx >> 5) * 3 + (((bx & 31) >> 3) - 1);
        gla_prep(lds, gj * 6, 6, Qb, Kb, Vb, LR, a.in[I_WGF], a.in[I_BGF], a.in[I_WGB], a.in[I_BGB], KS, QD, VT, DEC, Of, Ob);
    }
    GRID_BAR();
    gla_scan(lds, ((bx & 7) * 4 + (bx >> 6)) * 8 + ((bx >> 3) & 7), G, KS, QD, VT, DEC, Of, Ob);
    GRID_BAR();
    { PHASE_IDS
      for (int task = gw; task < NB * 1023; task += NGW) { const int b = task / 1023, row = 1 + task % 1023;
          const bf16_t* src = Ff + (size_t)(b * SEQ + row) * FNW; bf16_t* dst = Ff + (size_t)(b * SEQ + SEQ - row) * FNW;
#pragma unroll
          for (int g = 0; g < 4; ++g) { const bf16_t* sg = src + g * 256; const int c = 4 * lane;
              const unsigned e0 = sg[(256 - c) & 255], e1 = sg[255 - c], e2 = sg[254 - c], e3 = sg[253 - c];
              u32x2 w; w.x = e0 | (e1 << 16); w.y = e2 | (e3 << 16); *(u32x2*)(dst + g * 256 + c) = w; } }
      for (int task = gw; task < 16 * 256; task += NGW) { const int bz = task >> 8, ch = task & 255;
          const bf16_t* xp = XT + (size_t)bz * 256 * 4096 + (size_t)ch * 4096; float sacc = 0.f;
#pragma unroll
          for (int it = 0; it < 4; ++it) { const bf16x8 xv = *(const bf16x8*)(xp + it * 512 + lane * 8);
#pragma unroll
              for (int e = 0; e < 8; e += 2) sacc += bf2f((unsigned short)xv[e]) - bf2f((unsigned short)xv[e + 1]); }
          sacc = wave_sum(sacc);
          if (lane == 0) Ff[(size_t)((bz >> 2) * SEQ + 1024) * FNW + (bz & 3) * 256 + ch] = (bf16_t)f2bfhw(sacc * 0.02209708691207961f); } }
    { PHASE_IDS
    for (int task = gw; task < NB * 32 * 4 * NH; task += NGW) { const int h = task & 3, ct = (task >> 2) & 3, n = (task >> 4) & 31, b = task >> 9, fr = lane & 15, fq = lane >> 4;
        f32x4 ov[16]; float ss = 0.f;
#pragma unroll
        for (int t = 0; t < 16; ++t) { const size_t o = ((((((size_t)(b * 32 + n) * 4 + h) * 8 + (t >> 1)) * 4 + ct) * 2 + (t & 1)) * 64 + lane) << 2;
            const f32x4 x = ld_bf4(Of + o) + ld_bf4(Ob + o); ov[t] = x; ss += (x[0] * x[0] + x[1] * x[1]) + (x[2] * x[2] + x[3] * x[3]); }
        ss += __shfl_xor(ss, 16); ss += __shfl_xor(ss, 32);
        const float rstd = rsqrtf(ss * (1.0f / DV) + EPS);
        const size_t ro = (size_t)(b * SEQ + n * 64 + 16 * ct + fr) * VW + h * DV + 4 * fq;
#pragma unroll
        for (int t = 0; t < 16; ++t) { const f32x4 gg = *(const f32x4*)(a.in[I_GGLA] + h * DV + t * 16 + 4 * fq);
            st_bf4(AG + ro + t * 16, ld_bf4(Rb + ro + t * 16) * (ov[t] * rstd * gg)); }
    } }
    GRID_BAR();

    {
        GemmP g{AG, WglaT, VW, VW, VW, 0, (long)((OFF_WFN - OFF_WGLA) / 2), (long)((OFF_FF - OFF_Q) / 2)}; SchedPair S; S.g = SchedGrid{32, 8, 32, G, bx};
        EpiYab E{GA, GB, out, Y};
        gemm_fast(lds, g, S, E);
    }
    GRID_BAR();
    float* slots1 = (float*)(ws + 320 * 1024); float* slots2 = (float*)(ws + 576 * 1024);
    {
        f32x4 xr[2][16]; Unit u;
        { f32x4 acc[2][2][4][2];
          { GemmP g{Y, WoT, DM, DM, DM, 0, 0}; SchedGrid S{32, 8, 32, G, bx}; gemm_fast_core<EpiNone, SchedGrid, true>(lds, g, S, EpiNone{}, acc, u); }
          epi_rows_part1<2, true>(lds, acc, u, a.in[I_X], mod, out, slots1, xr); }
        xcd_barrier_light(xbar);
        int tid2 = threadIdx.x; asm volatile("" : "+v"(tid2));
        { const int wid2 = __builtin_amdgcn_readfirstlane(tid2 >> 6), colg = u.pn * BM + 4 * (tid2 & 63); const float* md = mod + ((u.pm * BM) >> 11) * MODW;
          const f32x4 gg = *(const f32x4*)(a.in[I_G2] + colg), sh = *(const f32x4*)(md + 3 * DM + colg), sc = *(const f32x4*)(md + 4 * DM + colg) + 1.0f;
#pragma unroll
          for (int ai = 0; ai < 2; ++ai)
#pragma unroll
              for (int j = 0; j < 16; ++j) { const int row = u.pm * BM + ai * HALF + wid2 * 16 + j; const float rstd = row_rstd(slots1, row);
                  st_bf4(H2 + (size_t)row * DM + colg, (xr[ai][j] * rstd * gg) * sc + sh); }
        }
    }
    GRID_BAR();
    {
        GemmP g{H2, WupT, DM, DM, DM, 0, 0}; SchedGrid S{32, 44, 32, G, bx};
        EpiUpConv E{a.in[I_CW], a.in[I_CB], ACT};
#if GEMM_FAST
        gemm_fast(lds, g, S, E);
#endif
    }
    if (bx >= 128) {
        PHASE_IDS
        LAS float* scr = (LAS float*)(lds + wave * 16384);
        for (int r = (bx - 128) * 8 + wave; r < 88 * 64; r += (G - 128) * 8)
            transpose_item(a.in[I_WDN], FF, DM, WdT, (r % 64) * 32, scr, (r / 64) * 64, (r % 64) * 32, lane);
    }
    GRID_BAR();
    {
        f32x4 xr[2][16]; Unit u;
        { f32x4 acc[2][2][4][2];
          { GemmP g{ACT, WdT, FF, FF, FF, 0, 0}; SchedGrid S{32, 8, 32, G, bx}; gemm_fast_core<EpiNone, SchedGrid, true>(lds, g, S, EpiNone{}, acc, u); }
          epi_rows_part1<5, false>(lds, acc, u, out, mod, out, slots2, xr); }
        xcd_barrier_light(xbar);
        int tid2 = threadIdx.x; asm volatile("" : "+v"(tid2));
        { const int wid2 = __builtin_amdgcn_readfirstlane(tid2 >> 6), colg = u.pn * BM + 4 * (tid2 & 63);
          const f32x4 gf = *(const f32x4*)(a.in[I_GF] + colg);
#pragma unroll
          for (int ai = 0; ai < 2; ++ai)
#pragma unroll
              for (int j = 0; j < 16; ++j) { const int row = u.pm * BM + ai * HALF + wid2 * 16 + j; const float rstd = row_rstd(slots2, row);
                  *(f32x4*)(out + (size_t)row * DM + colg) = xr[ai][j] * rstd * gf; }
        }
    }
}

extern "C" void kernel_launch(void* const* d_in, const int* in_sizes, int n_in, void* d_out, int out_size, void* d_ws, size_t ws_size, hipStream_t stream) {
    static int grid = 0;
    if (grid == 0) {
        if (n_in != N_IN || out_size != M * DM || ws_size < WS_END) { fprintf(stderr, "kernel_launch: unexpected shapes: n_in %d out %d ws %zu (need %zu)\n", n_in, out_size, ws_size, (size_t)WS_END); grid = -1; return; }
        int dev = 0, cus = 0, per_cu = 0;
        (void)hipGetDevice(&dev);
        (void)hipDeviceGetAttribute(&cus, hipDeviceAttributeMultiprocessorCount, dev);
        if (hipFuncSetAttribute((const void*)fwd_kernel, hipFuncAttributeMaxDynamicSharedMemorySize, LDS_BYTES) != hipSuccess) { fprintf(stderr, "kernel_launch: hipFuncSetAttribute failed\n"); grid = -1; return; }
        (void)hipOccupancyMaxActiveBlocksPerMultiprocessor(&per_cu, (const void*)fwd_kernel, NTHR, LDS_BYTES);
        if (per_cu < 1) { fprintf(stderr, "kernel_launch: occupancy query reports %d blocks per CU\n", per_cu); grid = -1; return; }
        if (cus != 256) { fprintf(stderr, "kernel_launch: built for a 256-CU device (one 256x256 unit per workgroup in the fused-norm GEMM phases), got %d\n", cus); grid = -1; return; }
        grid = cus;
    }
    if (grid < 0) return;
    Args a{};
    for (int i = 0; i < N_IN; ++i) a.in[i] = (const float*)d_in[i];
    a.out = (float*)d_out; a.ws = (unsigned char*)d_ws;
    void* args[] = {&a};
    hipError_t e = hipLaunchCooperativeKernel((const void*)fwd_kernel, dim3(grid), dim3(NTHR), args, LDS_BYTES, stream);
    if (e != hipSuccess) fprintf(stderr, "kernel_launch: cooperative launch failed: %s (grid %d)\n", hipGetErrorString(e), grid);
}
```

```cpp
#include <hip/hip_runtime.h>
#include <hip/hip_cooperative_groups.h>
#include <cstdio>
#include <cstdint>
namespace cg = cooperative_groups;

#ifndef GEMM_FAST
#define GEMM_FAST 1
#endif

#define LAS __attribute__((address_space(3)))
typedef unsigned short bf16_t;
typedef short bf16x8 __attribute__((ext_vector_type(8)));
typedef float f32x4 __attribute__((ext_vector_type(4)));
typedef unsigned u32x4 __attribute__((ext_vector_type(4)));
typedef unsigned u32x2 __attribute__((ext_vector_type(2)));

constexpr int DM = 2048, NB = 4, SEQ = 2048, M = NB * SEQ, CTX = 256, MC = NB * CTX, MT = M + MC;
constexpr int NH = 4, DK = 128, DV = 256, RANK = 16, FF = 5632, F2 = 2 * FF, INW = 8224, NPROJ = 8448;
constexpr int QKW = 512, VW = 1024, FNW = 1024, MODW = 6 * DM;
constexpr float EPS = 1e-6f;
enum { I_X = 0, I_C, I_CTX, I_CCTX, I_WADA, I_BADA, I_G1, I_WIN, I_WGF, I_BGF, I_WGB, I_BGB, I_GGLA, I_WGLA, I_WFN, I_WOUT, I_G2, I_WUP, I_CW, I_CB, I_WDN, I_GF, N_IN };

constexpr size_t MiB = 1u << 20;
constexpr size_t CTL_ZERO_BYTES = 1 * MiB;
constexpr size_t OFF_MOD = 65536;
constexpr size_t OFF_WIN = 1 * MiB;
constexpr size_t OFF_WGLA = 34 * MiB;
constexpr size_t OFF_WFN = 38 * MiB;
constexpr size_t OFF_WO = 42 * MiB;
constexpr size_t OFF_WUP = 50 * MiB;
constexpr size_t OFF_WD = 94 * MiB;
constexpr size_t OFF_DT = 116 * MiB;
constexpr size_t OFF_CS = 132 * MiB;
constexpr size_t OFF_A = 133 * MiB;
constexpr size_t OFF_Q = 169 * MiB;
constexpr size_t OFF_K = 177 * MiB;
constexpr size_t OFF_V = 186 * MiB;
constexpr size_t OFF_R = 204 * MiB;
constexpr size_t OFF_F = 220 * MiB;
constexpr size_t OFF_GA = 236 * MiB;
constexpr size_t OFF_GB = 268 * MiB;
constexpr size_t OFF_LR = 300 * MiB;
constexpr size_t OFF_FF = 305 * MiB;
constexpr size_t OFF_OF = 321 * MiB;
constexpr size_t OFF_OB = 353 * MiB;
constexpr size_t WS_END = 385 * MiB;
constexpr size_t OFF_U = 169 * MiB;
constexpr size_t OFF_ACT = 257 * MiB;

constexpr int LDS_BYTES = 147456;
constexpr int NTHR = 512;

__device__ __forceinline__ float bf2f(unsigned short h) { return __uint_as_float((unsigned)h << 16); }
__device__ __forceinline__ unsigned f2bf(float f) { unsigned u = __float_as_uint(f); return (u + 0x7fffu + ((u >> 16) & 1u)) >> 16; }
typedef __bf16 bf16v2_t __attribute__((ext_vector_type(2)));
__device__ __forceinline__ unsigned pk2hw(float lo, float hi) { bf16v2_t v; v[0] = (__bf16)lo; v[1] = (__bf16)hi; return __builtin_bit_cast(unsigned, v); }
__device__ __forceinline__ unsigned pk2(float lo, float hi) { return pk2hw(lo, hi); }
__device__ __forceinline__ unsigned f2bfhw(float f) { return (unsigned)__builtin_bit_cast(unsigned short, (__bf16)f); }
__device__ __forceinline__ f32x4 ld_bf4(const bf16_t* p) { u32x2 w = *(const u32x2*)p; return (f32x4){__uint_as_float(w.x << 16), __uint_as_float(w.x & 0xffff0000u), __uint_as_float(w.y << 16), __uint_as_float(w.y & 0xffff0000u)}; }
__device__ __forceinline__ void st_bf4(bf16_t* p, f32x4 v) { u32x2 w; w.x = pk2(v[0], v[1]); w.y = pk2(v[2], v[3]); *(u32x2*)p = w; }
__device__ __forceinline__ float sigmoidf_(float x) { return __builtin_amdgcn_rcpf(1.f + __expf(-x)); }
__device__ __forceinline__ float wave_sum(float v) {
#pragma unroll
    for (int o = 1; o < 64; o <<= 1) v += __shfl_xor(v, o);
    return v;
}

constexpr int BM = 256, BK = 64, HALF = 128, HTB = HALF * BK * 2, NXCD = 8, WGM = 8;
struct Unit { int pm, pn, bz; };
struct GemmP {
    const bf16_t* A; const bf16_t* Bt; int lda, ldb, K; long sB1, sB2, sA2;
    __device__ __forceinline__ const bf16_t* aptr(const Unit& u) const { return A + (size_t)(u.bz & 3) * sA2 + (size_t)u.pm * BM * lda; }
    __device__ __forceinline__ const bf16_t* bptr(const Unit& u) const { return Bt + (size_t)(u.bz >> 2) * sB1 + (size_t)(u.bz & 3) * sB2 + (size_t)u.pn * BM * ldb; }
};
struct SchedGrid {
    int nMt, nN, nMb, G, c;
    __device__ __forceinline__ bool decode(int L, Unit& u) const {
        const int nwg = nMt * nN; if (L >= nwg) return false;
        int wgid = L; { const int q = nwg / NXCD, r = nwg % NXCD, xcd = wgid % NXCD, off = wgid / NXCD; wgid = (xcd < r ? xcd * (q + 1) : r * (q + 1) + (xcd - r) * q) + off; }
        const int nig = WGM * nN, gid = wgid / nig, fm = gid * WGM, gsz = (nMt - fm) < WGM ? (nMt - fm) : WGM;
        const int pmt = fm + ((wgid % nig) % gsz); u.pn = (wgid % nig) / gsz; u.bz = pmt / nMb; u.pm = pmt % nMb; return true;
    }
    __device__ __forceinline__ bool next(int i, Unit& u) const { return decode(i * G + c, u); }
};
struct SchedProj {
    SchedGrid g;
    __device__ __forceinline__ bool next(int i, Unit& u) const {
        const int L = i * g.G + g.c;
        if (L < 32 * 33) return g.decode(L, u);
        const int j = L - 32 * 33; if (j >= 28) return false;
        const int t = j >> 2; u.pm = 32 + (j & 3); u.pn = t < 6 ? t + 2 : 32; u.bz = 0; return true;
    }
};

struct EpiProj { static constexpr bool TILE = false;
    bf16_t *Q, *Kb, *Vb, *R, *F, *GA, *GB, *LR;
    __device__ __forceinline__ void put(const Unit& u, int row, int col, f32x4 v) const {
        const int pn = u.pn; bf16_t* base; int ldc, c0, act = 0;
        if (pn < 2) { base = Q; ldc = 512; c0 = 0; act = 1; }
        else if (pn < 4) { base = Kb; ldc = 512; c0 = 512; }
        else if (pn < 8) { base = Vb; ldc = 1024; c0 = 1024; }
        else if (pn < 12) { base = R; ldc = 1024; c0 = 2048; act = 2; }
        else if (pn < 16) { base = F; ldc = 1024; c0 = 3072; }
        else if (pn < 24) { base = GA; ldc = 2048; c0 = 4096; act = 3; }
        else if (pn < 32) { base = GB; ldc = 2048; c0 = 6144; act = 3; }
        else { base = LR; ldc = 256; c0 = 8192; }
        if (act == 1) v = v * 0.08838834764831845f;
        else if (act == 2) { v[0] *= sigmoidf_(v[0]); v[1] *= sigmoidf_(v[1]); v[2] *= sigmoidf_(v[2]); v[3] *= sigmoidf_(v[3]); }
        else if (act == 3) { v[0] = sigmoidf_(v[0]); v[1] = sigmoidf_(v[1]); v[2] = sigmoidf_(v[2]); v[3] = sigmoidf_(v[3]); }
        st_bf4(base + (size_t)row * ldc + (col - c0), v);
    }
};
struct EpiFn1 { static constexpr bool TILE = false; bf16_t* XT;
    __device__ __forceinline__ void put(const Unit& u, int row, int col, f32x4 v) const {
        st_bf4(XT + (size_t)u.bz * 256 * 4096 + (size_t)(row & 255) * 4096 + (row >> 8) * 2048 + col, v); } };
struct EpiFn2 { static constexpr bool TILE = false; bf16_t* Ff; float scale;
    __device__ __forceinline__ void put(const Unit& u, int row, int col, f32x4 v) const {
        st_bf4(Ff + (size_t)((u.bz >> 2) * SEQ + row) * FNW + (u.bz & 3) * 256 + col, v * scale); } };
struct EpiFn2S { static constexpr bool TILE = false; bf16_t* Ff; float scale;
    __device__ __forceinline__ void put(const Unit& u, int row, int col, f32x4 v) const {
        st_bf4(Ff + (size_t)((u.bz >> 2) * SEQ + row) * FNW + (u.bz & 3) * 256 + col, v * scale); } };
struct SchedPair { SchedGrid g;
    __device__ __forceinline__ bool next(int i, Unit& u) const { if (i >= 2) return false; const bool ok = g.decode(g.c, u); u.bz = i; return ok; } };
struct EpiYab { static constexpr bool TILE = false; const bf16_t* GA; const bf16_t* GB; float* YA; bf16_t* Y;
    __device__ __forceinline__ void put(const Unit& u, int row, int col, f32x4 v) const {
        const size_t o = (size_t)row * DM + col;
        if (u.bz == 0) st_bf4((bf16_t*)YA + o, ld_bf4(GA + o) * v);
        else st_bf4(Y + o, ld_bf4((const bf16_t*)YA + o) + ld_bf4(GB + o) * v); } };
struct EpiYa { static constexpr bool TILE = false; const bf16_t* GA; float* YA;
    __device__ __forceinline__ void put(const Unit& u, int row, int col, f32x4 v) const {
        const size_t o = (size_t)row * DM + col; *(f32x4*)(YA + o) = ld_bf4(GA + o) * v; } };
struct EpiYb { static constexpr bool TILE = false; const bf16_t* GB; const float* YA; bf16_t* Y;
    __device__ __forceinline__ void put(const Unit& u, int row, int col, f32x4 v) const {
        const size_t o = (size_t)row * DM + col; st_bf4(Y + o, *(const f32x4*)(YA + o) + ld_bf4(GB + o) * v); } };
struct EpiOut { static constexpr bool TILE = false; const float* x; const float* mod; float* X1;
    __device__ __forceinline__ void put(const Unit& u, int row, int col, f32x4 v) const {
        const size_t o = (size_t)row * DM + col; const f32x4 gt = *(const f32x4*)(mod + (row >> 11) * MODW + 2 * DM + col);
        *(f32x4*)(X1 + o) = *(const f32x4*)(x + o) + gt * v; } };
struct EpiUp { static constexpr bool TILE = false; bf16_t* U;
    __device__ __forceinline__ void put(const Unit& u, int row, int col, f32x4 v) const { st_bf4(U + (size_t)row * F2 + col, v); } };
struct EpiDown { static constexpr bool TILE = false; const float* mod; float* X;
    __device__ __forceinline__ void put(const Unit& u, int row, int col, f32x4 v) const {
        const size_t o = (size_t)row * DM + col; const f32x4 gt = *(const f32x4*)(mod + (row >> 11) * MODW + 5 * DM + col);
        *(f32x4*)(X + o) = *(const f32x4*)(X + o) + gt * v; } };

__device__ __forceinline__ float dpp_ror1(float v) { return __int_as_float(__builtin_amdgcn_update_dpp(0, __float_as_int(v), 0x121, 0xf, 0xf, false)); }
__device__ __forceinline__ float dpp_rol1(float v) { return __int_as_float(__builtin_amdgcn_update_dpp(0, __float_as_int(v), 0x12F, 0xf, 0xf, false)); }
struct EpiUpConv { static constexpr bool TILE = true;
    const float* cw; const float* cb; bf16_t* ACT;
    __device__ __forceinline__ void put(const Unit&, int, int, f32x4) const {}
    __device__ __forceinline__ void tile(const f32x4 (&acc)[2][2][4][2], const Unit& u, int wr, int wc, int fr, int fq) const {
#pragma unroll
        for (int n = 0; n < 2; ++n) {
            const int cv = 128 * u.pn + 32 * wc + 16 * n + 4 * fq, cg = FF + cv;
            const f32x4 wv0 = *(const f32x4*)(cw + cv), wv1 = *(const f32x4*)(cw + F2 + cv), wv2 = *(const f32x4*)(cw + 2 * F2 + cv), bv = *(const f32x4*)(cb + cv);
            const f32x4 wg0 = *(const f32x4*)(cw + cg), wg1 = *(const f32x4*)(cw + F2 + cg), wg2 = *(const f32x4*)(cw + 2 * F2 + cg), bg = *(const f32x4*)(cb + cg);
#pragma unroll
            for (int ai = 0; ai < 2; ++ai)
#pragma unroll
                for (int m = 0; m < 4; ++m) {
                    f32x4 r;
#pragma unroll
                    for (int i = 0; i < 4; ++i) {
                        const float xv = acc[ai][0][m][n][i], xg = acc[ai][1][m][n][i];
                        const float uv = m > 0 ? acc[ai][0][m > 0 ? m - 1 : 0][n][i] : 0.f, ug = m > 0 ? acc[ai][1][m > 0 ? m - 1 : 0][n][i] : 0.f;
                        const float dv = m < 3 ? acc[ai][0][m < 3 ? m + 1 : 3][n][i] : 0.f, dg = m < 3 ? acc[ai][1][m < 3 ? m + 1 : 3][n][i] : 0.f;
                        const float pv = dpp_ror1(fr == 15 ? uv : xv), pg = dpp_ror1(fr == 15 ? ug : xg);
                        const float nv = dpp_rol1(fr == 0 ? dv : xv), ng = dpp_rol1(fr == 0 ? dg : xg);
                        const float yv = wv0[i] * pv + wv1[i] * xv + wv2[i] * nv + bv[i];
                        const float yg = wg0[i] * pg + wg1[i] * xg + wg2[i] * ng + bg[i];
                        r[i] = yg * sigmoidf_(yg) * yv;
                    }
                    st_bf4(ACT + (size_t)(u.pm * BM + ai * HALF + wr * 64 + m * 16 + fr) * FF + cv, r);
                }
        }
    }
};

template <class Epi, class Sched>
__device__ __forceinline__ void gemm_naive(const GemmP g, const Sched& S, const Epi& E) {
    const int tid = threadIdx.x, rg = tid >> 3, cgi = tid & 7;
    Unit u;
    for (int i = 0; S.next(i, u); ++i) {
        const bf16_t* A = g.aptr(u) + (size_t)(rg * 4) * g.lda; const bf16_t* B = g.bptr(u);
        for (int j = 0; j < 8; ++j) {
            const int c = j * 32 + cgi * 4;
            const bf16_t* Bc = B + (size_t)c * g.ldb;
            float acc[4][4];
#pragma unroll
            for (int r = 0; r < 4; ++r)
#pragma unroll
                for (int cc = 0; cc < 4; ++cc) acc[r][cc] = 0.f;
            for (int k = 0; k < g.K; k += 8) {
                bf16x8 a[4], b[4];
#pragma unroll
                for (int r = 0; r < 4; ++r) { a[r] = *(const bf16x8*)(A + (size_t)r * g.lda + k); b[r] = *(const bf16x8*)(Bc + (size_t)r * g.ldb + k); }
#pragma unroll
                for (int e = 0; e < 8; ++e)
#pragma unroll
                    for (int r = 0; r < 4; ++r)
#pragma unroll
                        for (int cc = 0; cc < 4; ++cc) acc[r][cc] += bf2f((unsigned short)a[r][e]) * bf2f((unsigned short)b[cc][e]);
            }
#pragma unroll
            for (int r = 0; r < 4; ++r) E.put(u, u.pm * BM + rg * 4 + r, u.pn * BM + c, (f32x4){acc[r][0], acc[r][1], acc[r][2], acc[r][3]});
        }
    }
}

__device__ __forceinline__ int lds_byte(int r, int c) { const int st = (r >> 4) * 2 + (c >> 5), rr = r & 15, cc = c & 31, ob = rr * 64 + cc * 2; return st * 1024 + (ob ^ (((ob >> 9) & 1) << 5)); }
__device__ __forceinline__ void stage_rc(int b, int& R, int& C) { const int st = b / 1024, sb = b % 1024, swz = sb ^ (((sb >> 9) & 1) << 5); R = (st >> 1) * 16 + swz / 64; C = (st & 1) * 32 + (swz % 64) / 2; }

template <class Epi, class Sched, bool DEFER>
__device__ __forceinline__ void gemm_fast_core(LAS unsigned char* lds, const GemmP g, const Sched& S, const Epi& E, f32x4 (&acc)[2][2][4][2], Unit& cur) {
    int tid = threadIdx.x; asm volatile("" : "+v"(tid));
    const int wid = __builtin_amdgcn_readfirstlane(tid >> 6), lane = tid & 63, wr = wid >> 2, wc = wid & 3, fr = lane & 15, fq = lane >> 4;
    const int K = g.K, nt = K / BK;
    unsigned voffA[2], voffB[2];
#pragma unroll
    for (int i = 0; i < 2; ++i) { int R, C; stage_rc(tid * 16 + i * 8192, R, C); voffA[i] = (unsigned)(R * g.lda + C) * 2u; voffB[i] = (unsigned)(R * g.ldb + C) * 2u; }
    const size_t kstep = (size_t)(BK * 2);
    const size_t hstepA = (size_t)HALF * g.lda * 2, hstepB = (size_t)HALF * g.ldb * 2;
    const unsigned ldsw = (unsigned)wid * 1024u;
    const int aoff = lds_byte(wr * 64 + fr, fq * 8), boff = lds_byte(wc * 32 + fr, fq * 8);
#define PG8_SA(b, h) (((b) * 2 + (h)) * HTB)
#define PG8_SB(b, h) ((4 + (b) * 2 + (h)) * HTB)
#define PG8_STAGE(bufoff, gbase, voff) do { _Pragma("unroll") for (int _i = 0; _i < 2; ++_i) \
        __builtin_amdgcn_global_load_lds((const unsigned*)((const char*)(gbase) + (voff)[_i]), (LAS unsigned*)(lds + (bufoff) + ldsw + _i * 8192), 16, 0, 0); } while (0)
#define PG8_LDA(dst, b, h) do { _Pragma("unroll") for (int m = 0; m < 4; ++m) _Pragma("unroll") for (int k = 0; k < 2; ++k) dst[m][k] = *(const LAS bf16x8*)(lds + PG8_SA(b, h) + aoff + m * 2048 + k * 1024); } while (0)
#define PG8_LDB(dst, b, h) do { _Pragma("unroll") for (int n = 0; n < 2; ++n) _Pragma("unroll") for (int k = 0; k < 2; ++k) dst[n][k] = *(const LAS bf16x8*)(lds + PG8_SB(b, h) + boff + n * 2048 + k * 1024); } while (0)
#define PG8_MMA(ai, bj, At, Bt) do { __builtin_amdgcn_s_setprio(1); _Pragma("unroll") for (int m = 0; m < 4; ++m) _Pragma("unroll") for (int n = 0; n < 2; ++n) _Pragma("unroll") for (int k = 0; k < 2; ++k) \
        acc[ai][bj][m][n] = __builtin_amdgcn_mfma_f32_16x16x32_bf16(Bt[n][k], At[m][k], acc[ai][bj][m][n], 0, 0, 0); __builtin_amdgcn_s_setprio(0); } while (0)
#define PG8_WAIT_V(n) asm volatile("s_waitcnt vmcnt(" #n ")" ::: "memory")
#define PG8_WAIT_L(n) asm volatile("s_waitcnt lgkmcnt(" #n ")" ::: "memory")
#define PG8_BAR __builtin_amdgcn_s_barrier()
#define PG8_SCHED __builtin_amdgcn_sched_barrier(0)
    Unit nxt; int ui = 0;
    if (!S.next(0, cur)) return;
#pragma unroll
    for (int a = 0; a < 2; ++a)
#pragma unroll
        for (int b = 0; b < 2; ++b)
#pragma unroll
            for (int m = 0; m < 4; ++m)
#pragma unroll
                for (int n = 0; n < 2; ++n) acc[a][b][m][n] = (f32x4){0.f, 0.f, 0.f, 0.f};
    bf16x8 At[4][2], B0[2][2], B1[2][2];
    const char* cA = (const char*)g.aptr(cur); const char* cB = (const char*)g.bptr(cur);
    PG8_STAGE(PG8_SB(0, 0), cB, voffB); PG8_STAGE(PG8_SB(0, 1), cB + hstepB, voffB); PG8_STAGE(PG8_SA(0, 0), cA, voffA); PG8_STAGE(PG8_SA(0, 1), cA + hstepA, voffA);
    if (wr == 1) PG8_BAR;
    PG8_WAIT_V(2); PG8_BAR;
    PG8_STAGE(PG8_SB(1, 0), cB + kstep, voffB); PG8_STAGE(PG8_SA(1, 0), cA + kstep, voffA); PG8_STAGE(PG8_SB(1, 1), cB + hstepB + kstep, voffB);
    PG8_WAIT_V(6); PG8_BAR;
    for (;;) {
        const bool has_next = S.next(ui + 1, nxt);
        const char* nA = has_next ? (const char*)g.aptr(nxt) : cA; const char* nB = has_next ? (const char*)g.bptr(nxt) : cB;
        for (int t = 0; t < nt; t += 2) {
            const bool last = (t == nt - 2);
            const char* a1 = cA + (size_t)(t + 1) * kstep;
            const char* a2 = last ? nA : cA + (size_t)(t + 2) * kstep; const char* b2 = last ? nB : cB + (size_t)(t + 2) * kstep;
            const char* a3 = a2 + kstep; const char* b3 = b2 + kstep;
            PG8_LDB(B0, 0, 0); PG8_LDB(B1, 0, 1); PG8_SCHED; PG8_LDA(At, 0, 0); PG8_STAGE(PG8_SA(1, 1), a1 + hstepA, voffA);
            PG8_WAIT_V(8); PG8_WAIT_L(0); PG8_BAR; PG8_MMA(0, 0, At, B0); PG8_MMA(0, 1, At, B1); PG8_BAR; PG8_SCHED;
            PG8_LDA(At, 0, 1); PG8_STAGE(PG8_SB(0, 0), b2, voffB); PG8_STAGE(PG8_SB(0, 1), b2 + hstepB, voffB); PG8_STAGE(PG8_SA(0, 0), a2, voffA);
            PG8_WAIT_V(8); PG8_WAIT_L(0); PG8_BAR; PG8_MMA(1, 0, At, B0); PG8_MMA(1, 1, At, B1); PG8_BAR; PG8_SCHED;
            PG8_LDB(B0, 1, 0); PG8_LDB(B1, 1, 1); PG8_SCHED; PG8_LDA(At, 1, 0); PG8_STAGE(PG8_SA(0, 1), a2 + hstepA, voffA);
            PG8_WAIT_V(8); PG8_WAIT_L(0); PG8_BAR; PG8_MMA(0, 0, At, B0); PG8_MMA(0, 1, At, B1); PG8_BAR; PG8_SCHED;
            PG8_LDA(At, 1, 1); PG8_STAGE(PG8_SB(1, 0), b3, voffB); PG8_STAGE(PG8_SB(1, 1), b3 + hstepB, voffB); PG8_STAGE(PG8_SA(1, 0), a3, voffA);
            PG8_WAIT_V(8); PG8_WAIT_L(0); PG8_BAR; PG8_MMA(1, 0, At, B0); PG8_MMA(1, 1, At, B1); PG8_BAR; PG8_SCHED;
        }
        if (wr == 0) PG8_BAR;
        if constexpr (DEFER) {   }
        else if constexpr (Epi::TILE) E.tile(acc, cur, wr, wc, fr, fq);
        else {
            const int row0 = cur.pm * BM + wr * 64 + fr, col0 = cur.pn * BM + wc * 32 + 4 * fq;
#pragma unroll
            for (int ai = 0; ai < 2; ++ai)
#pragma unroll
                for (int m = 0; m < 4; ++m)
#pragma unroll
                    for (int bj = 0; bj < 2; ++bj)
#pragma unroll
                        for (int n = 0; n < 2; ++n) E.put(cur, row0 + ai * HALF + m * 16, col0 + bj * HALF + n * 16, acc[ai][bj][m][n]);
        }
        if (!has_next) break;
#pragma unroll
        for (int a = 0; a < 2; ++a)
#pragma unroll
            for (int b = 0; b < 2; ++b)
#pragma unroll
                for (int m = 0; m < 4; ++m)
#pragma unroll
                    for (int n = 0; n < 2; ++n) acc[a][b][m][n] = (f32x4){0.f, 0.f, 0.f, 0.f};
        cur = nxt; cA = nA; cB = nB; ++ui;
        if (wr == 1) PG8_BAR;
    }
    PG8_WAIT_V(0);
    PG8_BAR;
#undef PG8_SA
#undef PG8_SB
#undef PG8_STAGE
#undef PG8_LDA
#undef PG8_LDB
#undef PG8_MMA
#undef PG8_WAIT_V
#undef PG8_WAIT_L
#undef PG8_BAR
#undef PG8_SCHED
}
template <class Epi, class Sched>
__device__ __forceinline__ void gemm_fast(LAS unsigned char* lds, const GemmP g, const Sched& S, const Epi& E) {
    f32x4 acc[2][2][4][2]; Unit cur;
    gemm_fast_core<Epi, Sched, false>(lds, g, S, E, acc, cur);
}
struct EpiNone { static constexpr bool TILE = false; __device__ __forceinline__ void put(const Unit&, int, int, f32x4) const {} };
__device__ __forceinline__ void tile_rowsq_publish(const f32x4 (&v)[2][2][4][2], const Unit& u, LAS unsigned char* lds, float* slots) {
    int tid = threadIdx.x; asm volatile("" : "+v"(tid));
    const int wid = __builtin_amdgcn_readfirstlane(tid >> 6), lane = tid & 63, wr = wid >> 2, wc = wid & 3, fr = lane & 15, fq = lane >> 4;
    LAS float* red = (LAS float*)lds;
#pragma unroll
    for (int ai = 0; ai < 2; ++ai)
#pragma unroll
        for (int m = 0; m < 4; ++m) { float sq = 0.f;
#pragma unroll
            for (int bj = 0; bj < 2; ++bj)
#pragma unroll
                for (int n = 0; n < 2; ++n) { const f32x4 x = v[ai][bj][m][n]; sq += (x[0] * x[0] + x[1] * x[1]) + (x[2] * x[2] + x[3] * x[3]); }
            sq += __shfl_xor(sq, 16); sq += __shfl_xor(sq, 32);
            if (fq == 0) red[(ai * HALF + wr * 64 + m * 16 + fr) * 4 + wc] = sq; }
    __syncthreads();
    if (tid < 256) { const f32x4 r = *(const LAS f32x4*)(red + tid * 4); slots[(size_t)(u.pm * BM + tid) * 8 + u.pn] = (r[0] + r[1]) + (r[2] + r[3]); }
}
__device__ __forceinline__ float row_rstd(const float* slots, int row) {
    const unsigned long long* sp = (const unsigned long long*)(slots + (size_t)row * 8); float t = 0.f;
#pragma unroll
    for (int q = 0; q < 4; ++q) { const unsigned long long w = __hip_atomic_load(sp + q, __ATOMIC_RELAXED, __HIP_MEMORY_SCOPE_AGENT); t += __uint_as_float((unsigned)w) + __uint_as_float((unsigned)(w >> 32)); }
    return rsqrtf(t * (1.0f / DM) + EPS);
}

template <class Epi, class Sched>
__device__ __forceinline__ void gemm_run(LAS unsigned char* lds, const GemmP g, const Sched& S, const Epi& E) {
#if GEMM_FAST
    gemm_fast(lds, g, S, E);
#else
    gemm_naive(g, S, E);
#endif
}


__device__ __forceinline__ f32x4 mma16(bf16x8 afrag, bf16x8 bfrag, f32x4 acc) { return __builtin_amdgcn_mfma_f32_16x16x32_bf16(bfrag, afrag, acc, 0, 0, 0); }
constexpr int GLA_NCH = 36;
template <int CTRL> __device__ __forceinline__ float dppz(float v) { return __int_as_float(__builtin_amdgcn_update_dpp(0, __float_as_int(v), CTRL, 0xf, 0xf, true)); }
#define LBAR() do { asm volatile("s_waitcnt lgkmcnt(0)" ::: "memory"); __builtin_amdgcn_s_barrier(); asm volatile("" ::: "memory"); } while (0)
__device__ __forceinline__ void gla_prep(LAS unsigned char* lds, int ufirst, int ucount, const bf16_t* Qb, const bf16_t* Kb, const bf16_t* Vb, const bf16_t* LR,
                                         const float* wgf, const float* bgf, const float* wgb, const float* bgb,
                                         bf16_t* KS, bf16_t* QD, bf16_t* VT, float* DEC, bf16_t* Of, bf16_t* Ob) {
    int tid = threadIdx.x; asm volatile("" : "+v"(tid));
    const int lane = tid & 63, wave = __builtin_amdgcn_readfirstlane(tid >> 6), fr = lane & 15, fq = lane >> 4;
    LAS bf16_t* qd = (LAS bf16_t*)lds; LAS bf16_t* kd = qd + 64 * 136; LAS bf16_t* sc = kd + 64 * 136; LAS bf16_t* vT = sc + 64 * 72;
    LAS bf16_t* ksT = vT + 256 * 72;
#pragma unroll 1
    for (int ui = 0; ui < ucount; ++ui) {
        const int unit = ufirst + ui;
        const int bh = unit / (2 * GLA_NCH), rem = unit % (2 * GLA_NCH), dir = rem / GLA_NCH, cidx = rem % GLA_NCH, b = bh >> 2, h = bh & 3;
        const bool lat = cidx >= 4;
        const int row0 = lat ? b * SEQ + (cidx - 4) * 64 : M + b * CTX + cidx * 64;
        const int kidx = (bh * 2 + dir) * GLA_NCH + cidx, qidx = (bh * 2 + dir) * 32 + (cidx - 4);
        const float* wsrc = dir ? wgb : wgf; const float* bsrc = dir ? bgb : bgf;
        LBAR();
        if (lat || dir == 0) {
#pragma unroll
            for (int j = 0; j < 4; ++j) { const int idx = tid + 512 * j, sp = idx & 63, c8 = (idx >> 6) * 8; const bf16x8 v = *(const bf16x8*)(Vb + (size_t)(row0 + sp) * VW + h * DV + c8);
#pragma unroll
                for (int e = 0; e < 8; ++e) vT[(c8 + e) * 72 + sp] = (bf16_t)v[e]; }
        }
        bf16x8 afr[4], bfr;
#pragma unroll
        for (int pt = 0; pt < 4; ++pt) afr[pt] = *(const bf16x8*)(LR + (size_t)(row0 + 16 * pt + fr) * 256 + dir * 16 + (fq & 1) * 8);
        { const float* wp = wsrc + (size_t)((fq & 1) * 8) * QKW + h * DK + 16 * wave + fr;
#pragma unroll
          for (int e = 0; e < 8; ++e) { const float wv = wp[e * QKW]; const unsigned hi = f2bfhw(wv); const float res = wv - bf2f((unsigned short)hi); bfr[e] = (short)(fq < 2 ? hi : f2bfhw(res)); } }
        const f32x4 bias4 = *(const f32x4*)(bsrc + h * DK + 16 * wave + 4 * fq);
        f32x4 k4[4], q4[4];
#pragma unroll
        for (int pt = 0; pt < 4; ++pt) { const size_t o = (size_t)(row0 + 16 * pt + fr) * QKW + h * DK + 16 * wave + 4 * fq; k4[pt] = ld_bf4(Kb + o); q4[pt] = lat ? ld_bf4(Qb + o) : (f32x4){0.f, 0.f, 0.f, 0.f}; }
        f32x4 la[4];
#pragma unroll
        for (int pt = 0; pt < 4; ++pt) { const f32x4 z = mma16(afr[pt], bfr, bias4);
#pragma unroll
            for (int i = 0; i < 4; ++i) { float x = (fminf(z[i], 0.f) - __logf(1.0f + __expf(-fabsf(z[i])))) * (1.0f / 16.0f);
                if (!dir) { x += dppz<0x111>(x); x += dppz<0x112>(x); x += dppz<0x114>(x); x += dppz<0x118>(x); }
                else      { x += dppz<0x101>(x); x += dppz<0x102>(x); x += dppz<0x104>(x); x += dppz<0x108>(x); }
                la[pt][i] = x; } }
        f32x4 carry = (f32x4){0.f, 0.f, 0.f, 0.f};
        if (!dir) {
#pragma unroll
            for (int pt = 0; pt < 4; ++pt) { f32x4 t;
#pragma unroll
                for (int i = 0; i < 4; ++i) t[i] = __shfl(la[pt][i], (lane & 48) | 15);
                la[pt] += carry; carry += t; }
        } else {
#pragma unroll
            for (int pt = 3; pt >= 0; --pt) { f32x4 t;
#pragma unroll
                for (int i = 0; i < 4; ++i) t[i] = __shfl(la[pt][i], lane & 48);
                la[pt] += carry; carry += t; }
        }
        const f32x4 blast = carry;
#pragma unroll
        for (int pt = 0; pt < 4; ++pt) { const int p = 16 * pt + fr;
            f32x4 ks, qn, kn;
#pragma unroll
            for (int i = 0; i < 4; ++i) { const float bv = la[pt][i]; ks[i] = k4[pt][i] * __expf(blast[i] - bv); qn[i] = q4[pt][i] * __expf(bv); kn[i] = k4[pt][i] * __expf(-bv); }
            const unsigned k01 = pk2hw(ks[0], ks[1]), k23 = pk2hw(ks[2], ks[3]);
            LAS bf16_t* kt = ksT + (16 * wave + 4 * fq) * 72 + p;
            kt[0] = (bf16_t)(k01 & 0xffffu); kt[72] = (bf16_t)(k01 >> 16); kt[144] = (bf16_t)(k23 & 0xffffu); kt[216] = (bf16_t)(k23 >> 16);
            if (lat) { u32x2 w; w.x = pk2hw(qn[0], qn[1]); w.y = pk2hw(qn[2], qn[3]); *(LAS u32x2*)(qd + p * 136 + 16 * wave + 4 * fq) = w;
                       w.x = pk2hw(kn[0], kn[1]); w.y = pk2hw(kn[2], kn[3]); *(LAS u32x2*)(kd + p * 136 + 16 * wave + 4 * fq) = w; } }
        if (fr == 0) { f32x4 dv; dv[0] = __expf(blast[0]); dv[1] = __expf(blast[1]); dv[2] = __expf(blast[2]); dv[3] = __expf(blast[3]); *(f32x4*)(DEC + kidx * 128 + 16 * wave + 4 * fq) = dv; }
        LBAR();
#pragma unroll
        for (int j = 0; j < 2; ++j) { const int idx = tid + 512 * j, dd = idx >> 3, part = idx & 7;
            *(u32x4*)(KS + (size_t)kidx * 8192 + ((((dd >> 4) * 2 + (part >> 2)) * 64 + (part & 3) * 16 + (dd & 15)) << 3)) = *(const LAS u32x4*)(ksT + dd * 72 + part * 8); }
        if (dir == 0) {
#pragma unroll
            for (int j = 0; j < 4; ++j) { const int idx = tid + 512 * j, v = idx >> 3, part = idx & 7;
                *(u32x4*)(VT + (size_t)(bh * GLA_NCH + cidx) * 16384 + ((((v >> 4) * 2 + (part >> 2)) * 64 + (part & 3) * 16 + (v & 15)) << 3)) = *(const LAS u32x4*)(vT + v * 72 + part * 8); }
        }
        if (lat) {
#pragma unroll
            for (int j = 0; j < 2; ++j) { const int idx = tid + 512 * j, pr = idx >> 4, part = idx & 15;
                *(u32x4*)(QD + (size_t)qidx * 8192 + ((((pr >> 4) * 4 + (part >> 2)) * 64 + (part & 3) * 16 + (pr & 15)) << 3)) = *(const LAS u32x4*)(qd + pr * 136 + part * 8); }
            { const int ct = wave >> 1; f32x4 acc[2] = {(f32x4){0.f, 0.f, 0.f, 0.f}, (f32x4){0.f, 0.f, 0.f, 0.f}};
#pragma unroll
                for (int k0 = 0; k0 < 4; ++k0) { const bf16x8 af = *(const LAS bf16x8*)(qd + (16 * ct + fr) * 136 + k0 * 32 + fq * 8);
#pragma unroll
                    for (int j = 0; j < 2; ++j) { const int st = (wave & 1) * 2 + j; const bf16x8 bf = *(const LAS bf16x8*)(kd + (16 * st + fr) * 136 + k0 * 32 + fq * 8); acc[j] = mma16(af, bf, acc[j]); } }
#pragma unroll
                for (int j = 0; j < 2; ++j) { const int st = (wave & 1) * 2 + j, c = 16 * ct + fr; f32x4 v = acc[j];
#pragma unroll
                    for (int i = 0; i < 4; ++i) { const int sp = 16 * st + 4 * fq + i; const bool keep = dir ? (sp >= c) : (sp <= c); v[i] = keep ? v[i] : 0.f; }
                    u32x2 w; w.x = pk2hw(v[0], v[1]); w.y = pk2hw(v[2], v[3]); *(LAS u32x2*)(sc + c * 72 + 16 * st + 4 * fq) = w; }
            }
            LBAR();
            { f32x4 acc[4][2];
#pragma unroll
                for (int ct = 0; ct < 4; ++ct) { acc[ct][0] = (f32x4){0.f, 0.f, 0.f, 0.f}; acc[ct][1] = (f32x4){0.f, 0.f, 0.f, 0.f}; }
#pragma unroll
                for (int k0 = 0; k0 < 2; ++k0) { bf16x8 bf[2];
#pragma unroll
                    for (int j = 0; j < 2; ++j) bf[j] = *(const LAS bf16x8*)(vT + (16 * (2 * wave + j) + fr) * 72 + k0 * 32 + fq * 8);
#pragma unroll
                    for (int ct = 0; ct < 4; ++ct) { const bf16x8 af = *(const LAS bf16x8*)(sc + (16 * ct + fr) * 72 + k0 * 32 + fq * 8);
                        acc[ct][0] = mma16(af, bf[0], acc[ct][0]); acc[ct][1] = mma16(af, bf[1], acc[ct][1]); } }
                bf16_t* O = dir ? Ob : Of;
#pragma unroll
                for (int ct = 0; ct < 4; ++ct)
#pragma unroll
                    for (int j = 0; j < 2; ++j) st_bf4(O + (((((((size_t)(b * 32 + cidx - 4) * 4 + h) * 8 + wave) * 4 + ct) * 2 + j) * 64 + lane) << 2), acc[ct][j]);
            }
        }
    }
    LBAR();
}
__device__ __forceinline__ void gla_scan(LAS unsigned char* lds, int bx, int G, const bf16_t* KS, const bf16_t* QD, const bf16_t* VT, const float* DEC, bf16_t* Of, bf16_t* Ob) {
    int tid = threadIdx.x; asm volatile("" : "+v"(tid));
    const int lane = tid & 63, wave = __builtin_amdgcn_readfirstlane(tid >> 6), fr = lane & 15, fq = lane >> 4;
    LAS bf16_t* ST = (LAS bf16_t*)lds;
    for (int unit = bx; unit < 256; unit += G) {
        const int vs = unit & 7, dir = (unit >> 3) & 1, bh = unit >> 4, b = bh >> 2, h = bh & 3;
        bf16_t* O = dir ? Ob : Of;
        f32x4 S0 = (f32x4){0.f, 0.f, 0.f, 0.f}, S1 = S0;
        const bf16x8 z8 = (bf16x8){0, 0, 0, 0, 0, 0, 0, 0};
#define GLB_DECL(P) bf16x8 P##ks0 = z8, P##ks1 = z8, P##v00 = z8, P##v01 = z8, P##v10 = z8, P##v11 = z8, P##q0 = z8, P##q1 = z8, P##q2 = z8, P##q3 = z8; float P##dec = 0.f; u32x2 P##oin = (u32x2){0u, 0u}; int P##row0 = 0;
        GLB_DECL(a_) GLB_DECL(b_) GLB_DECL(c_)
#define GLB_LOAD(step_, P) do { const int st_ = (step_); if (st_ < GLA_NCH) { const int cidx_ = st_ < 4 ? (dir ? 3 - st_ : st_) : (dir ? 39 - st_ : st_); \
        const int kidx_ = (bh * 2 + dir) * GLA_NCH + cidx_; const bf16_t* ksp_ = KS + (size_t)kidx_ * 8192 + ((wave * 2 * 64 + lane) << 3); \
        P##ks0 = *(const bf16x8*)ksp_; P##ks1 = *(const bf16x8*)(ksp_ + 512); \
        const bf16_t* vtp_ = VT + (size_t)(bh * GLA_NCH + cidx_) * 16384 + ((vs * 4 * 64 + lane) << 3); \
        P##v00 = *(const bf16x8*)vtp_; P##v01 = *(const bf16x8*)(vtp_ + 512); P##v10 = *(const bf16x8*)(vtp_ + 1024); P##v11 = *(const bf16x8*)(vtp_ + 1536); \
        P##dec = DEC[kidx_ * 128 + 16 * wave + fr]; \
        if (cidx_ >= 4) { const bf16_t* qp_ = QD + (size_t)((bh * 2 + dir) * 32 + cidx_ - 4) * 8192 + (((wave >> 1) * 4 * 64 + lane) << 3); \
            P##q0 = *(const bf16x8*)qp_; P##q1 = *(const bf16x8*)(qp_ + 512); P##q2 = *(const bf16x8*)(qp_ + 1024); P##q3 = *(const bf16x8*)(qp_ + 1536); \
            P##row0 = cidx_ - 4; \
            P##oin = *(const u32x2*)(O + (((((((size_t)(b * 32 + P##row0) * 4 + h) * 8 + vs) * 4 + (wave >> 1)) * 2 + (wave & 1)) * 64 + lane) << 2)); } } } while (0)
#define GLB_STEP(step_, P) do { const int sp_ = (step_); \
        if (sp_ >= 4) { const LAS bf16_t* stb = ST + ((sp_ - 1) & 1) * (32 * 136) + (16 * (wave & 1) + fr) * 136 + fq * 8; \
            f32x4 acc = (f32x4){0.f, 0.f, 0.f, 0.f}; \
            acc = mma16(P##q0, *(const LAS bf16x8*)(stb), acc); acc = mma16(P##q1, *(const LAS bf16x8*)(stb + 32), acc); \
            acc = mma16(P##q2, *(const LAS bf16x8*)(stb + 64), acc); acc = mma16(P##q3, *(const LAS bf16x8*)(stb + 96), acc); \
            const f32x4 oi_ = (f32x4){__uint_as_float(P##oin.x << 16), __uint_as_float(P##oin.x & 0xffff0000u), __uint_as_float(P##oin.y << 16), __uint_as_float(P##oin.y & 0xffff0000u)}; \
            st_bf4(O + (((((((size_t)(b * 32 + P##row0) * 4 + h) * 8 + vs) * 4 + (wave >> 1)) * 2 + (wave & 1)) * 64 + lane) << 2), oi_ + acc); } \
        S0 = S0 * P##dec; S1 = S1 * P##dec; \
        S0 = mma16(P##ks0, P##v00, S0); S0 = mma16(P##ks1, P##v01, S0); S1 = mma16(P##ks0, P##v10, S1); S1 = mma16(P##ks1, P##v11, S1); \
        { LAS bf16_t* stw = ST + (sp_ & 1) * (32 * 136) + 16 * wave + fr; \
          _Pragma("unroll") for (int i = 0; i < 4; ++i) { stw[(4 * fq + i) * 136] = (bf16_t)f2bfhw(S0[i]); stw[(16 + 4 * fq + i) * 136] = (bf16_t)f2bfhw(S1[i]); } } \
        asm volatile("s_waitcnt lgkmcnt(0)" ::: "memory"); __builtin_amdgcn_s_barrier(); asm volatile("" ::: "memory"); } while (0)
        __syncthreads();
        GLB_LOAD(0, a_); GLB_LOAD(1, b_);
        for (int step = 0; step < GLA_NCH; step += 3) {
            GLB_LOAD(step + 2, c_); GLB_STEP(step, a_);
            GLB_LOAD(step + 3, a_); GLB_STEP(step + 1, b_);
            GLB_LOAD(step + 4, b_); GLB_STEP(step + 2, c_);
        }
#undef GLB_STEP
#undef GLB_DECL
#undef GLB_LOAD
    }
    __syncthreads();
}

#define XB_TMO      128
#define XB_XCNT(j)  (256  + 64 * (j))
#define XB_XSUB(j)  (1280 + 64 * (j))
#define XB_XGEN(j)  (2304 + 64 * (j))
#define XB_TOP      3328
#define XB_TOPGEN   3392
#define XCD_BAR_WORDS 3456
#define XB_SPIN_CAP (1u << 18)

__device__ __forceinline__ unsigned xb_ld(unsigned* p)              { return __hip_atomic_load(p, __ATOMIC_RELAXED, __HIP_MEMORY_SCOPE_AGENT); }
__device__ __forceinline__ unsigned xb_add(unsigned* p, unsigned v) { return __hip_atomic_fetch_add(p, v, __ATOMIC_RELAXED, __HIP_MEMORY_SCOPE_AGENT); }
__device__ __forceinline__ unsigned xb_xcc_id() { return (unsigned)__builtin_amdgcn_s_getreg((3 << 11) | 20) & 0xFu; }
#define XB_SPIN(cond, bar) do { unsigned _sp = 0; while (cond) { __builtin_amdgcn_s_sleep(1); \
    if ((++_sp & 255u) == 0u) { if (xb_ld(&(bar)[XB_TMO])) break; if (_sp > XB_SPIN_CAP) { atomicAdd(&(bar)[XB_TMO], 1u); break; } } } } while (0)

struct XcdBarrier {
    unsigned* bar; unsigned x;
    volatile LAS unsigned* st;
};

__device__ __forceinline__ XcdBarrier xcd_barrier_post(unsigned* bar, volatile LAS unsigned* st) {
    XcdBarrier b; b.bar = bar; b.x = xb_xcc_id(); b.st = st;
    if (threadIdx.x == 0) (void)xb_add(&bar[XB_XCNT(b.x)], 1u);
    return b;
}
__device__ __forceinline__ void xcd_barrier_complete(unsigned* bar, unsigned x, unsigned& nloc, unsigned& nx) {
    const unsigned G = gridDim.x * gridDim.y * gridDim.z;
    unsigned sum, cnt, mine, sp = 0u;
    for (;;) {
        sum = 0u; cnt = 0u; mine = 0u;
#pragma unroll
        for (unsigned j = 0; j < 16; ++j) { const unsigned c = xb_ld(&bar[XB_XCNT(j)]); sum += c; cnt += (c > 0u) ? 1u : 0u; mine = (j == x) ? c : mine; }
        if (sum == G) break;
        __builtin_amdgcn_s_sleep(1);
        if ((++sp & 255u) == 0u) { if (xb_ld(&bar[XB_TMO])) break; if (sp > XB_SPIN_CAP) { atomicAdd(&bar[XB_TMO], 1u); break; } }
    }
    nloc = mine > 0u ? mine : 1u; nx = cnt > 0u ? cnt : 1u;
}

__device__ __forceinline__ void xcd_barrier(const XcdBarrier& b) {
    asm volatile("s_waitcnt vmcnt(0)" ::: "memory");
    __syncthreads();
    if (threadIdx.x == 0) {
        unsigned* bar = b.bar;
        __builtin_amdgcn_s_waitcnt(0);
        unsigned nloc = b.st[0], nx = b.st[1];
        if (nloc == 0u) { xcd_barrier_complete(bar, b.x, nloc, nx); b.st[0] = nloc; b.st[1] = nx; }
        const unsigned old = xb_add(&bar[XB_XSUB(b.x)], 1u);
        const unsigned gen = old / nloc;
        if (old + 1u == (gen + 1u) * nloc) {
            __builtin_amdgcn_fence(__ATOMIC_RELEASE, "agent");
            asm volatile("s_waitcnt vmcnt(0)" ::: "memory");
            const unsigned og = xb_add(&bar[XB_TOP], 1u);
            const unsigned tg = og / nx;
            if (og + 1u == (tg + 1u) * nx) xb_add(&bar[XB_TOPGEN], 1u);
            else XB_SPIN(xb_ld(&bar[XB_TOPGEN]) == tg, bar);
            __builtin_amdgcn_fence(__ATOMIC_ACQUIRE, "agent");
            xb_add(&bar[XB_XGEN(b.x)], 1u);
            asm volatile("s_waitcnt vmcnt(0)" ::: "memory");
        } else {
            XB_SPIN(xb_ld(&bar[XB_XGEN(b.x)]) == gen, bar);
            __builtin_amdgcn_fence(__ATOMIC_ACQUIRE, "agent");
            asm volatile("s_waitcnt vmcnt(0)" ::: "memory");
        }
    }
    __syncthreads();
}
__device__ __forceinline__ void xcd_barrier_light(const XcdBarrier& b) {
    asm volatile("s_waitcnt vmcnt(0)" ::: "memory");
    __syncthreads();
    if (threadIdx.x == 0) {
        unsigned* bar = b.bar;
        __builtin_amdgcn_s_waitcnt(0);
        unsigned nloc = b.st[0], nx = b.st[1];
        if (nloc == 0u) { xcd_barrier_complete(bar, b.x, nloc, nx); b.st[0] = nloc; b.st[1] = nx; }
        const unsigned old = xb_add(&bar[XB_XSUB(b.x)], 1u);
        const unsigned gen = old / nloc;
        if (old + 1u == (gen + 1u) * nloc) {
            asm volatile("s_waitcnt vmcnt(0)" ::: "memory");
            const unsigned og = xb_add(&bar[XB_TOP], 1u);
            const unsigned tg = og / nx;
            if (og + 1u == (tg + 1u) * nx) xb_add(&bar[XB_TOPGEN], 1u);
            else XB_SPIN(xb_ld(&bar[XB_TOPGEN]) == tg, bar);
            xb_add(&bar[XB_XGEN(b.x)], 1u);
            asm volatile("s_waitcnt vmcnt(0)" ::: "memory");
        } else {
            XB_SPIN(xb_ld(&bar[XB_XGEN(b.x)]) == gen, bar);
            asm volatile("s_waitcnt vmcnt(0)" ::: "memory");
        }
    }
    __syncthreads();
}

__device__ __forceinline__ void transpose_item(const float* W, int K, int N, bf16_t* WT, int drow0, LAS float* scr, int k0, int n0, int lane) {
#pragma unroll 8
    for (int i = 0; i < 32; ++i) { const int kk = 2 * i + (lane >> 5); scr[kk * 33 + (lane & 31)] = W[(size_t)(k0 + kk) * N + n0 + (lane & 31)]; }
    asm volatile("s_waitcnt lgkmcnt(0)" ::: "memory");
    const int c = lane & 7;
#pragma unroll
    for (int j = 0; j < 4; ++j) { const int n = (lane >> 3) + 8 * j; const LAS float* s = scr + (8 * c) * 33 + n;
        u32x4 o; o.x = pk2(s[0 * 33], s[1 * 33]); o.y = pk2(s[2 * 33], s[3 * 33]); o.z = pk2(s[4 * 33], s[5 * 33]); o.w = pk2(s[6 * 33], s[7 * 33]);
        *(u32x4*)(WT + (size_t)(drow0 + n) * K + k0 + 8 * c) = o; }
    asm volatile("s_waitcnt lgkmcnt(0)" ::: "memory");
}

template <int MODOFF, int STORE  , bool BASE_BF16>
__device__ __forceinline__ void epi_rows_part1(LAS unsigned char* lds, const f32x4 (&acc)[2][2][4][2], const Unit& u, const float* base, const float* mod, float* outp, float* slots, f32x4 (&xr)[2][16]) {
    int tid = threadIdx.x; asm volatile("" : "+v"(tid));
    const int wid = __builtin_amdgcn_readfirstlane(tid >> 6), lane = tid & 63, wr = wid >> 2, wc = wid & 3, fr = lane & 15, fq = lane >> 4;
    LAS float* T = (LAS float*)lds;
    const int colg = u.pn * BM + 4 * lane;
    const f32x4 gt = *(const f32x4*)(mod + ((u.pm * BM) >> 11) * MODW + MODOFF * DM + colg);
#pragma unroll
    for (int ai = 0; ai < 2; ++ai) {
        if (ai) LBAR();
#pragma unroll
        for (int m = 0; m < 4; ++m)
#pragma unroll
            for (int bj = 0; bj < 2; ++bj)
#pragma unroll
                for (int n = 0; n < 2; ++n) { const int rl = wr * 64 + m * 16 + fr, c4 = (bj * HALF + wc * 32 + n * 16 + 4 * fq) >> 2;
                    *(LAS f32x4*)(T + rl * 256 + ((c4 ^ (rl & 15)) << 2)) = acc[ai][bj][m][n]; }
        LBAR();
#pragma unroll
        for (int j = 0; j < 16; ++j) { const int rl = wid * 16 + j, row = u.pm * BM + ai * HALF + rl; const size_t o = (size_t)row * DM + colg;
            const f32x4 v = *(const LAS f32x4*)(T + rl * 256 + ((lane ^ j) << 2));
            const f32x4 bs = BASE_BF16 ? ld_bf4((const bf16_t*)base + o) : *(const f32x4*)(base + o);
            const f32x4 x1 = bs + gt * v; xr[ai][j] = x1; if (STORE == 2) st_bf4((bf16_t*)outp + o, x1);
            const float sq = wave_sum((x1[0] * x1[0] + x1[1] * x1[1]) + (x1[2] * x1[2] + x1[3] * x1[3]));
            if (lane == 0) __hip_atomic_store((unsigned*)slots + (size_t)row * 8 + u.pn, __float_as_uint(sq), __ATOMIC_RELAXED, __HIP_MEMORY_SCOPE_AGENT); }
    }
}

struct Args { const float* in[N_IN]; float* out; unsigned char* ws; };

__global__ void __launch_bounds__(NTHR, 2) fwd_kernel(Args a) {
    extern __shared__ __attribute__((aligned(16))) unsigned char lds_raw[];
    LAS unsigned char* lds = (LAS unsigned char*)lds_raw;
    cg::grid_group grid = cg::this_grid();
    const int G = gridDim.x, bx = blockIdx.x, NGW = G * 8, NT = G * NTHR;
    if (threadIdx.x < 64) ((LAS unsigned*)(lds + 131072))[threadIdx.x] = 0u;
    if (bx == 0) for (int i = threadIdx.x; i < XCD_BAR_WORDS; i += NTHR) __hip_atomic_store((unsigned*)(a.ws + 16384) + i, 0u, __ATOMIC_RELAXED, __HIP_MEMORY_SCOPE_AGENT);
    __syncthreads();
    grid.sync();
    const XcdBarrier xbar = xcd_barrier_post((unsigned*)(a.ws + 16384), (volatile LAS unsigned*)(lds + 131072 + 32));
#define GRID_BAR() xcd_barrier(xbar)
#define PHASE_IDS int tid = threadIdx.x; asm volatile("" : "+v"(tid)); const int lane = tid & 63, wave = __builtin_amdgcn_readfirstlane(tid >> 6), gw = bx * 8 + wave, gtid = bx * NTHR + tid; (void)lane; (void)gw; (void)gtid;
    unsigned char* ws = a.ws;
    float* mod = (float*)(ws + OFF_MOD);
    bf16_t* WinT = (bf16_t*)(ws + OFF_WIN); bf16_t* WglaT = (bf16_t*)(ws + OFF_WGLA); bf16_t* WfnT = (bf16_t*)(ws + OFF_WFN); bf16_t* WoT = (bf16_t*)(ws + OFF_WO);
    bf16_t* WupT = (bf16_t*)(ws + OFF_WUP); bf16_t* WdT = (bf16_t*)(ws + OFF_WD); bf16_t* DT = (bf16_t*)(ws + OFF_DT); bf16_t* CS = (bf16_t*)(ws + OFF_CS);
    bf16_t* H1 = (bf16_t*)(ws + OFF_A); bf16_t* XT = H1; bf16_t* Y = H1; bf16_t* H2 = H1;
    bf16_t* Qb = (bf16_t*)(ws + OFF_Q); bf16_t* Kb = (bf16_t*)(ws + OFF_K); bf16_t* Vb = (bf16_t*)(ws + OFF_V); bf16_t* Rb = (bf16_t*)(ws + OFF_R);
    bf16_t* Fb = (bf16_t*)(ws + OFF_F); bf16_t* GA = (bf16_t*)(ws + OFF_GA); bf16_t* GB = (bf16_t*)(ws + OFF_GB); bf16_t* LR = (bf16_t*)(ws + OFF_LR);
    bf16_t* Ff = (bf16_t*)(ws + OFF_FF); bf16_t* Of = (bf16_t*)(ws + OFF_OF); bf16_t* Ob = (bf16_t*)(ws + OFF_OB);
    bf16_t* AG = Qb; bf16_t* U = (bf16_t*)(ws + OFF_U); bf16_t* ACT = (bf16_t*)(ws + OFF_ACT);
    float* out = a.out;

    {
        PHASE_IDS
        LAS float* scr = (LAS float*)(lds + wave * 16384);
        constexpr int IT_IN = 32 * 257, IT_GLA = 16 * 64, IT_FN = 16 * 64, IT_OUT = 32 * 64;
        (void)IT_GLA; (void)IT_FN; (void)IT_OUT;
        for (int it = gw; it < IT_IN; it += NGW) {
            const int r = it, kb = r / 257, nb = r % 257, n0 = nb * 32; const int d0 = n0 < 3072 ? n0 : (n0 == 3072 ? 8192 : n0 - 32);
            transpose_item(a.in[I_WIN], DM, INW, WinT, d0, scr, kb * 64, n0, lane);
        }
        for (int i = gtid; i < 224 * 256; i += NT) ((u32x4*)(WinT + (size_t)8224 * DM))[i] = (u32x4){0u, 0u, 0u, 0u};
        for (int gi = gtid; gi < 2048 * 512; gi += NT) {
            const int k1 = gi >> 9, j0 = (gi & 511) * 8; float v[8];
#pragma unroll
            for (int e = 0; e < 8; ++e) { const int j = j0 + e; const int ph = (k1 * (j & 2047)) & 2047; const float x = (float)ph * (1.0f / 1024.0f); v[e] = j < 2048 ? cospif(x) : -sinpif(x); }
            u32x4 o; o.x = pk2(v[0], v[1]); o.y = pk2(v[2], v[3]); o.z = pk2(v[4], v[5]); o.w = pk2(v[6], v[7]);
            *(u32x4*)(DT + (size_t)k1 * 4096 + j0) = o;
        }
        for (int gi = gtid; gi < 512 * 32; gi += NT) {
            const int m = gi >> 5, c0 = (gi & 31) * 8; float v[8];
#pragma unroll
            for (int e = 0; e < 8; ++e) { const int ph = ((m & 255) * (c0 + e)) & 255; const float x = (float)ph * (1.0f / 128.0f); v[e] = (m < 256 ? cospif(x) : sinpif(x)) * 0.0625f; }
            u32x4 o; o.x = pk2(v[0], v[1]); o.y = pk2(v[2], v[3]); o.z = pk2(v[4], v[5]); o.w = pk2(v[6], v[7]);
            *(u32x4*)(CS + (size_t)m * 256 + c0) = o;
        }
    }
    {
        PHASE_IDS
        LAS float* sl = (LAS float*)lds;
        LAS float* red = sl + 5 * DM;
        __syncthreads();
        for (int i = tid; i < 5 * DM; i += NTHR) { const float c = i < 4 * DM ? a.in[I_C][i] : a.in[I_CCTX][i - 4 * DM]; sl[i] = c * sigmoidf_(c); }
        __syncthreads();
        for (int cb = bx; cb < 256; cb += G) {
            const int col = cb * 48 + (lane < 48 ? lane : 47);
            float acc[5] = {0.f, 0.f, 0.f, 0.f, 0.f};
            const float* wp = a.in[I_WADA] + (size_t)(wave * 256) * MODW + col;
#pragma unroll 16
            for (int kk = 0; kk < 256; ++kk) {
                const float w = wp[(size_t)kk * MODW];
#pragma unroll
                for (int r = 0; r < 5; ++r) acc[r] += w * sl[r * DM + wave * 256 + kk];
            }
            if (lane < 48) {
#pragma unroll
                for (int r = 0; r < 5; ++r) red[(wave * 5 + r) * 48 + lane] = acc[r];
            }
            __syncthreads();
            if (tid < 240) { const int r = tid / 48, c = tid % 48; float s = a.in[I_BADA][cb * 48 + c];
#pragma unroll
                for (int w = 0; w < 8; ++w) s += red[(w * 5 + r) * 48 + c];
                mod[r * MODW + cb * 48 + c] = s; }
            __syncthreads();
        }
    }
    GRID_BAR();

    { PHASE_IDS
    for (int m = gw; m < MT; m += NGW) {
        const float* src = m < M ? a.in[I_X] + (size_t)m * DM : a.in[I_CTX] + (size_t)(m - M) * DM;
        const float* md = mod + (m < M ? (m >> 11) : 4) * MODW;
        f32x4 v[8]; float ss = 0.f;
#pragma unroll
        for (int j = 0; j < 8; ++j) { v[j] = *(const f32x4*)(src + j * 256 + lane * 4); ss += (v[j][0] * v[j][0] + v[j][1] * v[j][1]) + (v[j][2] * v[j][2] + v[j][3] * v[j][3]); }
        const float rstd = rsqrtf(wave_sum(ss) * (1.0f / DM) + EPS);
#pragma unroll
        for (int j = 0; j < 8; ++j) { const int c = j * 256 + lane * 4;
            const f32x4 g = *(const f32x4*)(a.in[I_G1] + c), sh = *(const f32x4*)(md + c), sc = *(const f32x4*)(md + DM + c);
            st_bf4(H1 + (size_t)m * DM + c, (v[j] * rstd * g) * (sc + 1.0f) + sh); }
    } }
    GRID_BAR();

    {
        GemmP g{H1, WinT, DM, DM, DM, 0, 0}; SchedProj S; S.g = SchedGrid{32, 33, 32, G, bx};
        EpiProj E{Qb, Kb, Vb, Rb, Fb, GA, GB, LR};
        gemm_run(lds, g, S, E);
    }
    {
        constexpr int LASTR = 32 * 33 + 28 - 1024;
        const int first = (G == 256) ? LASTR : 0;
        if (bx >= first) {
            PHASE_IDS
            LAS float* scr = (LAS float*)(lds + wave * 16384);
            constexpr int IT_UP = 32 * 352, IT_DN = 88 * 64;
            const int gw2 = (bx - first) * 8 + wave, NGW2 = (G - first) * 8;
            constexpr int IT_GLA = 16 * 64, IT_FN = 16 * 64, IT_OUT = 32 * 64;
            for (int it = gw2; it < IT_UP + IT_GLA + IT_FN + IT_OUT; it += NGW2) {
                int r = it;
                if (r >= IT_UP) { r -= IT_UP;
                    if (r < IT_GLA) { transpose_item(a.in[I_WGLA], VW, DM, WglaT, (r % 64) * 32, scr, (r / 64) * 64, (r % 64) * 32, lane); continue; } r -= IT_GLA;
                    if (r < IT_FN) { transpose_item(a.in[I_WFN], FNW, DM, WfnT, (r % 64) * 32, scr, (r / 64) * 64, (r % 64) * 32, lane); continue; } r -= IT_FN;
                    transpose_item(a.in[I_WOUT], DM, DM, WoT, (r % 64) * 32, scr, (r / 64) * 64, (r % 64) * 32, lane); continue; }
                if (r < IT_UP) { const int n0 = (r % 352) * 32, j = n0 < FF ? n0 : n0 - FF; transpose_item(a.in[I_WUP], DM, F2, WupT, (j >> 7) * 256 + (n0 < FF ? 0 : 128) + (j & 127), scr, (r / 352) * 64, n0, lane); continue; } r -= IT_UP;
                transpose_item(a.in[I_WDN], FF, DM, WdT, (r % 64) * 32, scr, (r / 64) * 64, (r % 64) * 32, lane);
            }
        }
    }
    GRID_BAR();

    {
        GemmP g{CS, Fb, 256, FNW, 256, (long)SEQ * FNW, 256}; SchedGrid S{32, 8, 2, G, bx};
        EpiFn1 E{XT};
        gemm_run(lds, g, S, E);
    }
    GRID_BAR();
    bf16_t* KS = (bf16_t*)out; bf16_t* QD = (bf16_t*)((unsigned char*)out + 18 * MiB); bf16_t* VT = (bf16_t*)((unsigned char*)out + 34 * MiB); float* DEC = (float*)((unsigned char*)out + 52 * MiB);
    if (((bx >> 3) & 3) == 0) {
        const int fj = (bx >> 5) * 8 + (bx & 7);
        { GemmP g{DT, XT, 4096, 4096, 4096, (long)4 * 256 * 4096, (long)256 * 4096}; SchedGrid S{64, 1, 4, 64, fj};
          EpiFn2S E{Ff, 0.02209708691207961f};
          gemm_fast(lds, g, S, E); }
    } else {
        const int gj = (bx >> 5) * 24 + (bx & 31) - 8;
        gla_prep(lds, gj * 6, 6, Qb, Kb, Vb, LR, a.in[I_WGF], a.in[I_BGF], a.in[I_WGB], a.in[I_BGB], KS, QD, VT, DEC, Of, Ob);
    }
    GRID_BAR();
    gla_scan(lds, ((bx & 7) * 4 + (bx >> 6)) * 8 + ((bx >> 3) & 7), G, KS, QD, VT, DEC, Of, Ob);
    GRID_BAR();
    { PHASE_IDS
      for (int task = gw; task < NB * 1023; task += NGW) { const int b = task / 1023, row = 1 + task % 1023;
          const bf16_t* src = Ff + (size_t)(b * SEQ + row) * FNW; bf16_t* dst = Ff + (size_t)(b * SEQ + SEQ - row) * FNW;
#pragma unroll
          for (int g = 0; g < 4; ++g) { const bf16_t* sg = src + g * 256; const int c = 4 * lane;
              const unsigned e0 = sg[(256 - c) & 255], e1 = sg[255 - c], e2 = sg[254 - c], e3 = sg[253 - c];
              u32x2 w; w.x = e0 | (e1 << 16); w.y = e2 | (e3 << 16); *(u32x2*)(dst + g * 256 + c) = w; } }
      for (int task = gw; task < 16 * 256; task += NGW) { const int bz = task >> 8, ch = task & 255;
          const bf16_t* xp = XT + (size_t)bz * 256 * 4096 + (size_t)ch * 4096; float sacc = 0.f;
#pragma unroll
          for (int it = 0; it < 4; ++it) { const bf16x8 xv = *(const bf16x8*)(xp + it * 512 + lane * 8);
#pragma unroll
              for (int e = 0; e < 8; e += 2) sacc += bf2f((unsigned short)xv[e]) - bf2f((unsigned short)xv[e + 1]); }
          sacc = wave_sum(sacc);
          if (lane == 0) Ff[(size_t)((bz >> 2) * SEQ + 1024) * FNW + (bz & 3) * 256 + ch] = (bf16_t)f2bfhw(sacc * 0.02209708691207961f); } }
    { PHASE_IDS
    for (int task = gw; task < NB * 32 * 4 * NH; task += NGW) { const int h = task & 3, ct = (task >> 2) & 3, n = (task >> 4) & 31, b = task >> 9, fr = lane & 15, fq = lane >> 4;
        f32x4 ov[16]; float ss = 0.f;
#pragma unroll
        for (int t = 0; t < 16; ++t) { const size_t o = ((((((size_t)(b * 32 + n) * 4 + h) * 8 + (t >> 1)) * 4 + ct) * 2 + (t & 1)) * 64 + lane) << 2;
            const f32x4 x = ld_bf4(Of + o) + ld_bf4(Ob + o); ov[t] = x; ss += (x[0] * x[0] + x[1] * x[1]) + (x[2] * x[2] + x[3] * x[3]); }
        ss += __shfl_xor(ss, 16); ss += __shfl_xor(ss, 32);
        const float rstd = rsqrtf(ss * (1.0f / DV) + EPS);
        const size_t ro = (size_t)(b * SEQ + n * 64 + 16 * ct + fr) * VW + h * DV + 4 * fq;
#pragma unroll
        for (int t = 0; t < 16; ++t) { const f32x4 gg = *(const f32x4*)(a.in[I_GGLA] + h * DV + t * 16 + 4 * fq);
            st_bf4(AG + ro + t * 16, ld_bf4(Rb + ro + t * 16) * (ov[t] * rstd * gg)); }
    } }
    GRID_BAR();

    {
        GemmP g{AG, WglaT, VW, VW, VW, 0, (long)((OFF_WFN - OFF_WGLA) / 2), (long)((OFF_FF - OFF_Q) / 2)}; SchedPair S; S.g = SchedGrid{32, 8, 32, G, bx};
        EpiYab E{GA, GB, out, Y};
        gemm_fast(lds, g, S, E);
    }
    GRID_BAR();
    float* slots1 = (float*)(ws + 320 * 1024); float* slots2 = (float*)(ws + 576 * 1024);
    {
        f32x4 xr[2][16]; Unit u;
        { f32x4 acc[2][2][4][2];
          { GemmP g{Y, WoT, DM, DM, DM, 0, 0}; SchedGrid S{32, 8, 32, G, bx}; gemm_fast_core<EpiNone, SchedGrid, true>(lds, g, S, EpiNone{}, acc, u); }
          epi_rows_part1<2, 2, false>(lds, acc, u, a.in[I_X], mod, out, slots1, xr); }
        xcd_barrier_light(xbar);
        int tid2 = threadIdx.x; asm volatile("" : "+v"(tid2));
        { const int wid2 = __builtin_amdgcn_readfirstlane(tid2 >> 6), colg = u.pn * BM + 4 * (tid2 & 63); const float* md = mod + ((u.pm * BM) >> 11) * MODW;
          const f32x4 gg = *(const f32x4*)(a.in[I_G2] + colg), sh = *(const f32x4*)(md + 3 * DM + colg), sc = *(const f32x4*)(md + 4 * DM + colg) + 1.0f;
#pragma unroll
          for (int ai = 0; ai < 2; ++ai)
#pragma unroll
              for (int j = 0; j < 16; ++j) { const int row = u.pm * BM + ai * HALF + wid2 * 16 + j; const float rstd = row_rstd(slots1, row);
                  st_bf4(H2 + (size_t)row * DM + colg, (xr[ai][j] * rstd * gg) * sc + sh); }
        }
    }
    GRID_BAR();
    {
        GemmP g{H2, WupT, DM, DM, DM, 0, 0}; SchedGrid S{32, 44, 32, G, bx};
        EpiUpConv E{a.in[I_CW], a.in[I_CB], ACT};
#if GEMM_FAST
        gemm_fast(lds, g, S, E);
#endif
    }
    if (bx >= 128) {
        PHASE_IDS
        LAS float* scr = (LAS float*)(lds + wave * 16384);
        for (int r = (bx - 128) * 8 + wave; r < 88 * 64; r += (G - 128) * 8)
            transpose_item(a.in[I_WDN], FF, DM, WdT, (r % 64) * 32, scr, (r / 64) * 64, (r % 64) * 32, lane);
    }
    GRID_BAR();
    {
        f32x4 xr[2][16]; Unit u;
        { f32x4 acc[2][2][4][2];
          { GemmP g{ACT, WdT, FF, FF, FF, 0, 0}; SchedGrid S{32, 8, 32, G, bx}; gemm_fast_core<EpiNone, SchedGrid, true>(lds, g, S, EpiNone{}, acc, u); }
          epi_rows_part1<5, 0, true>(lds, acc, u, out, mod, out, slots2, xr); }
        xcd_barrier_light(xbar);
        int tid2 = threadIdx.x; asm volatile("" : "+v"(tid2));
        { const int wid2 = __builtin_amdgcn_readfirstlane(tid2 >> 6), colg = u.pn * BM + 4 * (tid2 & 63);
          const f32x4 gf = *(const f32x4*)(a.in[I_GF] + colg);
#pragma unroll
          for (int ai = 0; ai < 2; ++ai)
#pragma unroll
              for (int j = 0; j < 16; ++j) { const int row = u.pm * BM + ai * HALF + wid2 * 16 + j; const float rstd = row_rstd(slots2, row);
                  *(f32x4*)(out + (size_t)row * DM + colg) = xr[ai][j] * rstd * gf; }
        }
    }
}

extern "C" void kernel_launch(void* const* d_in, const int* in_sizes, int n_in, void* d_out, int out_size, void* d_ws, size_t ws_size, hipStream_t stream) {
    static int grid = 0;
    if (grid == 0) {
        if (n_in != N_IN || out_size != M * DM || ws_size < WS_END) { fprintf(stderr, "kernel_launch: unexpected shapes: n_in %d out %d ws %zu (need %zu)\n", n_in, out_size, ws_size, (size_t)WS_END); grid = -1; return; }
        int dev = 0, cus = 0, per_cu = 0;
        (void)hipGetDevice(&dev);
        (void)hipDeviceGetAttribute(&cus, hipDeviceAttributeMultiprocessorCount, dev);
        if (hipFuncSetAttribute((const void*)fwd_kernel, hipFuncAttributeMaxDynamicSharedMemorySize, LDS_BYTES) != hipSuccess) { fprintf(stderr, "kernel_launch: hipFuncSetAttribute failed\n"); grid = -1; return; }
        (void)hipOccupancyMaxActiveBlocksPerMultiprocessor(&per_cu, (const void*)fwd_kernel, NTHR, LDS_BYTES);
        if (per_cu < 1) { fprintf(stderr, "kernel_launch: occupancy query reports %d blocks per CU\n", per_cu); grid = -1; return; }
        if (cus != 256) { fprintf(stderr, "kernel_launch: built for a 256-CU device (one 256x256 unit per workgroup in the fused-norm GEMM phases), got %d\n", cus); grid = -1; return; }
        grid = cus;
    }
    if (grid < 0) return;
    Args a{};
    for (int i = 0; i < N_IN; ++i) a.in[i] = (const float*)d_in[i];
    a.out = (float*)d_out; a.ws = (unsigned char*)d_ws;
    void* args[] = {&a};
    hipError_t e = hipLaunchCooperativeKernel((const void*)fwd_kernel, dim3(grid), dim3(NTHR), args, LDS_BYTES, stream);
    if (e != hipSuccess) fprintf(stderr, "kernel_launch: cooperative launch failed: %s (grid %d)\n", hipGetErrorString(e), grid);
}
```

```cpp
#include <hip/hip_runtime.h>
#include <hip/hip_cooperative_groups.h>
#include <cstdio>
#include <cstdint>
namespace cg = cooperative_groups;

#ifndef GEMM_FAST
#define GEMM_FAST 1
#endif

#define LAS __attribute__((address_space(3)))
typedef unsigned short bf16_t;
typedef short bf16x8 __attribute__((ext_vector_type(8)));
typedef float f32x4 __attribute__((ext_vector_type(4)));
typedef unsigned u32x4 __attribute__((ext_vector_type(4)));
typedef unsigned u32x2 __attribute__((ext_vector_type(2)));

constexpr int DM = 2048, NB = 4, SEQ = 2048, M = NB * SEQ, CTX = 256, MC = NB * CTX, MT = M + MC;
constexpr int NH = 4, DK = 128, DV = 256, RANK = 16, FF = 5632, F2 = 2 * FF, INW = 8224, NPROJ = 8448;
constexpr int QKW = 512, VW = 1024, FNW = 1024, MODW = 6 * DM;
constexpr float EPS = 1e-6f;
enum { I_X = 0, I_C, I_CTX, I_CCTX, I_WADA, I_BADA, I_G1, I_WIN, I_WGF, I_BGF, I_WGB, I_BGB, I_GGLA, I_WGLA, I_WFN, I_WOUT, I_G2, I_WUP, I_CW, I_CB, I_WDN, I_GF, N_IN };

constexpr size_t MiB = 1u << 20;
constexpr size_t CTL_ZERO_BYTES = 1 * MiB;
constexpr size_t OFF_MOD = 65536;
constexpr size_t OFF_WIN = 1 * MiB;
constexpr size_t OFF_WGLA = 34 * MiB;
constexpr size_t OFF_WFN = 38 * MiB;
constexpr size_t OFF_WO = 42 * MiB;
constexpr size_t OFF_WUP = 50 * MiB;
constexpr size_t OFF_WD = 94 * MiB;
constexpr size_t OFF_DT = 116 * MiB;
constexpr size_t OFF_CS = 132 * MiB;
constexpr size_t OFF_A = 133 * MiB;
constexpr size_t OFF_Q = 169 * MiB;
constexpr size_t OFF_K = 177 * MiB;
constexpr size_t OFF_V = 186 * MiB;
constexpr size_t OFF_R = 204 * MiB;
constexpr size_t OFF_F = 220 * MiB;
constexpr size_t OFF_GA = 236 * MiB;
constexpr size_t OFF_GB = 268 * MiB;
constexpr size_t OFF_LR = 300 * MiB;
constexpr size_t OFF_FF = 305 * MiB;
constexpr size_t OFF_OF = 321 * MiB;
constexpr size_t OFF_OB = 353 * MiB;
constexpr size_t WS_END = 385 * MiB;
constexpr size_t OFF_U = 169 * MiB;
constexpr size_t OFF_ACT = 257 * MiB;

constexpr int LDS_BYTES = 147456;
constexpr int NTHR = 512;

__device__ __forceinline__ float bf2f(unsigned short h) { return __uint_as_float((unsigned)h << 16); }
__device__ __forceinline__ unsigned f2bf(float f) { unsigned u = __float_as_uint(f); return (u + 0x7fffu + ((u >> 16) & 1u)) >> 16; }
typedef __bf16 bf16v2_t __attribute__((ext_vector_type(2)));
__device__ __forceinline__ unsigned pk2hw(float lo, float hi) { bf16v2_t v; v[0] = (__bf16)lo; v[1] = (__bf16)hi; return __builtin_bit_cast(unsigned, v); }
__device__ __forceinline__ unsigned pk2(float lo, float hi) { return pk2hw(lo, hi); }
__device__ __forceinline__ unsigned f2bfhw(float f) { return (unsigned)__builtin_bit_cast(unsigned short, (__bf16)f); }
__device__ __forceinline__ f32x4 ld_bf4(const bf16_t* p) { u32x2 w = *(const u32x2*)p; return (f32x4){__uint_as_float(w.x << 16), __uint_as_float(w.x & 0xffff0000u), __uint_as_float(w.y << 16), __uint_as_float(w.y & 0xffff0000u)}; }
__device__ __forceinline__ void st_bf4(bf16_t* p, f32x4 v) { u32x2 w; w.x = pk2(v[0], v[1]); w.y = pk2(v[2], v[3]); *(u32x2*)p = w; }
__device__ __forceinline__ float sigmoidf_(float x) { return __builtin_amdgcn_rcpf(1.f + __expf(-x)); }
__device__ __forceinline__ float wave_sum(float v) {
#pragma unroll
    for (int o = 1; o < 64; o <<= 1) v += __shfl_xor(v, o);
    return v;
}

constexpr int BM = 256, BK = 64, HALF = 128, HTB = HALF * BK * 2, NXCD = 8, WGM = 8;
struct Unit { int pm, pn, bz; };
struct GemmP {
    const bf16_t* A; const bf16_t* Bt; int lda, ldb, K; long sB1, sB2, sA2;
    __device__ __forceinline__ const bf16_t* aptr(const Unit& u) const { return A + (size_t)(u.bz & 3) * sA2 + (size_t)u.pm * BM * lda; }
    __device__ __forceinline__ const bf16_t* bptr(const Unit& u) const { return Bt + (size_t)(u.bz >> 2) * sB1 + (size_t)(u.bz & 3) * sB2 + (size_t)u.pn * BM * ldb; }
};
struct SchedGrid {
    int nMt, nN, nMb, G, c;
    __device__ __forceinline__ bool decode(int L, Unit& u) const {
        const int nwg = nMt * nN; if (L >= nwg) return false;
        int wgid = L; { const int q = nwg / NXCD, r = nwg % NXCD, xcd = wgid % NXCD, off = wgid / NXCD; wgid = (xcd < r ? xcd * (q + 1) : r * (q + 1) + (xcd - r) * q) + off; }
        const int nig = WGM * nN, gid = wgid / nig, fm = gid * WGM, gsz = (nMt - fm) < WGM ? (nMt - fm) : WGM;
        const int pmt = fm + ((wgid % nig) % gsz); u.pn = (wgid % nig) / gsz; u.bz = pmt / nMb; u.pm = pmt % nMb; return true;
    }
    __device__ __forceinline__ bool next(int i, Unit& u) const { return decode(i * G + c, u); }
};
struct SchedProj {
    SchedGrid g;
    __device__ __forceinline__ bool next(int i, Unit& u) const {
        const int L = i * g.G + g.c;
        if (L < 32 * 33) return g.decode(L, u);
        const int j = L - 32 * 33; if (j >= 28) return false;
        const int t = j >> 2; u.pm = 32 + (j & 3); u.pn = t < 6 ? t + 2 : 32; u.bz = 0; return true;
    }
};

struct EpiProj { static constexpr bool TILE = false;
    bf16_t *Q, *Kb, *Vb, *R, *F, *GA, *GB, *LR;
    __device__ __forceinline__ void put(const Unit& u, int row, int col, f32x4 v) const {
        const int pn = u.pn; bf16_t* base; int ldc, c0, act = 0;
        if (pn < 2) { base = Q; ldc = 512; c0 = 0; act = 1; }
        else if (pn < 4) { base = Kb; ldc = 512; c0 = 512; }
        else if (pn < 8) { base = Vb; ldc = 1024; c0 = 1024; }
        else if (pn < 12) { base = R; ldc = 1024; c0 = 2048; act = 2; }
        else if (pn < 16) { base = F; ldc = 1024; c0 = 3072; }
        else if (pn < 24) { base = GA; ldc = 2048; c0 = 4096; act = 3; }
        else if (pn < 32) { base = GB; ldc = 2048; c0 = 6144; act = 3; }
        else { base = LR; ldc = 256; c0 = 8192; }
        if (act == 1) v = v * 0.08838834764831845f;
        else if (act == 2) { v[0] *= sigmoidf_(v[0]); v[1] *= sigmoidf_(v[1]); v[2] *= sigmoidf_(v[2]); v[3] *= sigmoidf_(v[3]); }
        else if (act == 3) { v[0] = sigmoidf_(v[0]); v[1] = sigmoidf_(v[1]); v[2] = sigmoidf_(v[2]); v[3] = sigmoidf_(v[3]); }
        st_bf4(base + (size_t)row * ldc + (col - c0), v);
    }
};
struct EpiFn1 { static constexpr bool TILE = false; bf16_t* XT;
    __device__ __forceinline__ void put(const Unit& u, int row, int col, f32x4 v) const {
        st_bf4(XT + (size_t)u.bz * 256 * 4096 + (size_t)(row & 255) * 4096 + (row >> 8) * 2048 + col, v); } };
struct EpiFn2 { static constexpr bool TILE = false; bf16_t* Ff; float scale;
    __device__ __forceinline__ void put(const Unit& u, int row, int col, f32x4 v) const {
        st_bf4(Ff + (size_t)((u.bz >> 2) * SEQ + row) * FNW + (u.bz & 3) * 256 + col, v * scale); } };
struct EpiFn2S { static constexpr bool TILE = false; bf16_t* Ff; float scale;
    __device__ __forceinline__ void put(const Unit& u, int row, int col, f32x4 v) const {
        st_bf4(Ff + (size_t)((u.bz >> 2) * SEQ + row) * FNW + (u.bz & 3) * 256 + col, v * scale); } };
struct SchedPair { SchedGrid g;
    __device__ __forceinline__ bool next(int i, Unit& u) const { if (i >= 2) return false; const bool ok = g.decode(g.c, u); u.bz = i; return ok; } };
struct EpiYab { static constexpr bool TILE = false; const bf16_t* GA; const bf16_t* GB; float* YA; bf16_t* Y;
    __device__ __forceinline__ void put(const Unit& u, int row, int col, f32x4 v) const {
        const size_t o = (size_t)row * DM + col;
        if (u.bz == 0) st_bf4((bf16_t*)YA + o, ld_bf4(GA + o) * v);
        else st_bf4(Y + o, ld_bf4((const bf16_t*)YA + o) + ld_bf4(GB + o) * v); } };
struct EpiYa { static constexpr bool TILE = false; const bf16_t* GA; float* YA;
    __device__ __forceinline__ void put(const Unit& u, int row, int col, f32x4 v) const {
        const size_t o = (size_t)row * DM + col; *(f32x4*)(YA + o) = ld_bf4(GA + o) * v; } };
struct EpiYb { static constexpr bool TILE = false; const bf16_t* GB; const float* YA; bf16_t* Y;
    __device__ __forceinline__ void put(const Unit& u, int row, int col, f32x4 v) const {
        const size_t o = (size_t)row * DM + col; st_bf4(Y + o, *(const f32x4*)(YA + o) + ld_bf4(GB + o) * v); } };
struct EpiOut { static constexpr bool TILE = false; const float* x; const float* mod; float* X1;
    __device__ __forceinline__ void put(const Unit& u, int row, int col, f32x4 v) const {
        const size_t o = (size_t)row * DM + col; const f32x4 gt = *(const f32x4*)(mod + (row >> 11) * MODW + 2 * DM + col);
        *(f32x4*)(X1 + o) = *(const f32x4*)(x + o) + gt * v; } };
struct EpiUp { static constexpr bool TILE = false; bf16_t* U;
    __device__ __forceinline__ void put(const Unit& u, int row, int col, f32x4 v) const { st_bf4(U + (size_t)row * F2 + col, v); } };
struct EpiDown { static constexpr bool TILE = false; const float* mod; float* X;
    __device__ __forceinline__ void put(const Unit& u, int row, int col, f32x4 v) const {
        const size_t o = (size_t)row * DM + col; const f32x4 gt = *(const f32x4*)(mod + (row >> 11) * MODW + 5 * DM + col);
        *(f32x4*)(X + o) = *(const f32x4*)(X + o) + gt * v; } };

__device__ __forceinline__ float dpp_ror1(float v) { return __int_as_float(__builtin_amdgcn_update_dpp(0, __float_as_int(v), 0x121, 0xf, 0xf, false)); }
__device__ __forceinline__ float dpp_rol1(float v) { return __int_as_float(__builtin_amdgcn_update_dpp(0, __float_as_int(v), 0x12F, 0xf, 0xf, false)); }
struct EpiUpConv { static constexpr bool TILE = true;
    const float* cw; const float* cb; bf16_t* ACT;
    __device__ __forceinline__ void put(const Unit&, int, int, f32x4) const {}
    __device__ __forceinline__ void tile(const f32x4 (&acc)[2][2][4][2], const Unit& u, int wr, int wc, int fr, int fq) const {
#pragma unroll
        for (int n = 0; n < 2; ++n) {
            const int cv = 128 * u.pn + 32 * wc + 16 * n + 4 * fq, cg = FF + cv;
            const f32x4 wv0 = *(const f32x4*)(cw + cv), wv1 = *(const f32x4*)(cw + F2 + cv), wv2 = *(const f32x4*)(cw + 2 * F2 + cv), bv = *(const f32x4*)(cb + cv);
            const f32x4 wg0 = *(const f32x4*)(cw + cg), wg1 = *(const f32x4*)(cw + F2 + cg), wg2 = *(const f32x4*)(cw + 2 * F2 + cg), bg = *(const f32x4*)(cb + cg);
#pragma unroll
            for (int ai = 0; ai < 2; ++ai)
#pragma unroll
                for (int m = 0; m < 4; ++m) {
                    f32x4 r;
#pragma unroll
                    for (int i = 0; i < 4; ++i) {
                        const float xv = acc[ai][0][m][n][i], xg = acc[ai][1][m][n][i];
                        const float uv = m > 0 ? acc[ai][0][m > 0 ? m - 1 : 0][n][i] : 0.f, ug = m > 0 ? acc[ai][1][m > 0 ? m - 1 : 0][n][i] : 0.f;
                        const float dv = m < 3 ? acc[ai][0][m < 3 ? m + 1 : 3][n][i] : 0.f, dg = m < 3 ? acc[ai][1][m < 3 ? m + 1 : 3][n][i] : 0.f;
                        const float pv = dpp_ror1(fr == 15 ? uv : xv), pg = dpp_ror1(fr == 15 ? ug : xg);
                        const float nv = dpp_rol1(fr == 0 ? dv : xv), ng = dpp_rol1(fr == 0 ? dg : xg);
                        const float yv = wv0[i] * pv + wv1[i] * xv + wv2[i] * nv + bv[i];
                        const float yg = wg0[i] * pg + wg1[i] * xg + wg2[i] * ng + bg[i];
                        r[i] = yg * sigmoidf_(yg) * yv;
                    }
                    st_bf4(ACT + (size_t)(u.pm * BM + ai * HALF + wr * 64 + m * 16 + fr) * FF + cv, r);
                }
        }
    }
};

template <class Epi, class Sched>
__device__ __forceinline__ void gemm_naive(const GemmP g, const Sched& S, const Epi& E) {
    const int tid = threadIdx.x, rg = tid >> 3, cgi = tid & 7;
    Unit u;
    for (int i = 0; S.next(i, u); ++i) {
        const bf16_t* A = g.aptr(u) + (size_t)(rg * 4) * g.lda; const bf16_t* B = g.bptr(u);
        for (int j = 0; j < 8; ++j) {
            const int c = j * 32 + cgi * 4;
            const bf16_t* Bc = B + (size_t)c * g.ldb;
            float acc[4][4];
#pragma unroll
            for (int r = 0; r < 4; ++r)
#pragma unroll
                for (int cc = 0; cc < 4; ++cc) acc[r][cc] = 0.f;
            for (int k = 0; k < g.K; k += 8) {
                bf16x8 a[4], b[4];
#pragma unroll
                for (int r = 0; r < 4; ++r) { a[r] = *(const bf16x8*)(A + (size_t)r * g.lda + k); b[r] = *(const bf16x8*)(Bc + (size_t)r * g.ldb + k); }
#pragma unroll
                for (int e = 0; e < 8; ++e)
#pragma unroll
                    for (int r = 0; r < 4; ++r)
#pragma unroll
                        for (int cc = 0; cc < 4; ++cc) acc[r][cc] += bf2f((unsigned short)a[r][e]) * bf2f((unsigned short)b[cc][e]);
            }
#pragma unroll
            for (int r = 0; r < 4; ++r) E.put(u, u.pm * BM + rg * 4 + r, u.pn * BM + c, (f32x4){acc[r][0], acc[r][1], acc[r][2], acc[r][3]});
        }
    }
}

__device__ __forceinline__ int lds_byte(int r, int c) { const int st = (r >> 4) * 2 + (c >> 5), rr = r & 15, cc = c & 31, ob = rr * 64 + cc * 2; return st * 1024 + (ob ^ (((ob >> 9) & 1) << 5)); }
__device__ __forceinline__ void stage_rc(int b, int& R, int& C) { const int st = b / 1024, sb = b % 1024, swz = sb ^ (((sb >> 9) & 1) << 5); R = (st >> 1) * 16 + swz / 64; C = (st & 1) * 32 + (swz % 64) / 2; }

template <class Epi, class Sched, bool DEFER>
__device__ __forceinline__ void gemm_fast_core(LAS unsigned char* lds, const GemmP g, const Sched& S, const Epi& E, f32x4 (&acc)[2][2][4][2], Unit& cur) {
    int tid = threadIdx.x; asm volatile("" : "+v"(tid));
    const int wid = __builtin_amdgcn_readfirstlane(tid >> 6), lane = tid & 63, wr = wid >> 2, wc = wid & 3, fr = lane & 15, fq = lane >> 4;
    const int K = g.K, nt = K / BK;
    unsigned voffA[2], voffB[2];
#pragma unroll
    for (int i = 0; i < 2; ++i) { int R, C; stage_rc(tid * 16 + i * 8192, R, C); voffA[i] = (unsigned)(R * g.lda + C) * 2u; voffB[i] = (unsigned)(R * g.ldb + C) * 2u; }
    const size_t kstep = (size_t)(BK * 2);
    const size_t hstepA = (size_t)HALF * g.lda * 2, hstepB = (size_t)HALF * g.ldb * 2;
    const unsigned ldsw = (unsigned)wid * 1024u;
    const int aoff = lds_byte(wr * 64 + fr, fq * 8), boff = lds_byte(wc * 32 + fr, fq * 8);
#define PG8_SA(b, h) (((b) * 2 + (h)) * HTB)
#define PG8_SB(b, h) ((4 + (b) * 2 + (h)) * HTB)
#define PG8_STAGE(bufoff, gbase, voff) do { _Pragma("unroll") for (int _i = 0; _i < 2; ++_i) \
        __builtin_amdgcn_global_load_lds((const unsigned*)((const char*)(gbase) + (voff)[_i]), (LAS unsigned*)(lds + (bufoff) + ldsw + _i * 8192), 16, 0, 0); } while (0)
#define PG8_LDA(dst, b, h) do { _Pragma("unroll") for (int m = 0; m < 4; ++m) _Pragma("unroll") for (int k = 0; k < 2; ++k) dst[m][k] = *(const LAS bf16x8*)(lds + PG8_SA(b, h) + aoff + m * 2048 + k * 1024); } while (0)
#define PG8_LDB(dst, b, h) do { _Pragma("unroll") for (int n = 0; n < 2; ++n) _Pragma("unroll") for (int k = 0; k < 2; ++k) dst[n][k] = *(const LAS bf16x8*)(lds + PG8_SB(b, h) + boff + n * 2048 + k * 1024); } while (0)
#define PG8_MMA(ai, bj, At, Bt) do { __builtin_amdgcn_s_setprio(1); _Pragma("unroll") for (int m = 0; m < 4; ++m) _Pragma("unroll") for (int n = 0; n < 2; ++n) _Pragma("unroll") for (int k = 0; k < 2; ++k) \
        acc[ai][bj][m][n] = __builtin_amdgcn_mfma_f32_16x16x32_bf16(Bt[n][k], At[m][k], acc[ai][bj][m][n], 0, 0, 0); __builtin_amdgcn_s_setprio(0); } while (0)
#define PG8_WAIT_V(n) asm volatile("s_waitcnt vmcnt(" #n ")" ::: "memory")
#define PG8_WAIT_L(n) asm volatile("s_waitcnt lgkmcnt(" #n ")" ::: "memory")
#define PG8_BAR __builtin_amdgcn_s_barrier()
#define PG8_SCHED __builtin_amdgcn_sched_barrier(0)
    Unit nxt; int ui = 0;
    if (!S.next(0, cur)) return;
#pragma unroll
    for (int a = 0; a < 2; ++a)
#pragma unroll
        for (int b = 0; b < 2; ++b)
#pragma unroll
            for (int m = 0; m < 4; ++m)
#pragma unroll
                for (int n = 0; n < 2; ++n) acc[a][b][m][n] = (f32x4){0.f, 0.f, 0.f, 0.f};
    bf16x8 At[4][2], B0[2][2], B1[2][2];
    const char* cA = (const char*)g.aptr(cur); const char* cB = (const char*)g.bptr(cur);
    PG8_STAGE(PG8_SB(0, 0), cB, voffB); PG8_STAGE(PG8_SB(0, 1), cB + hstepB, voffB); PG8_STAGE(PG8_SA(0, 0), cA, voffA); PG8_STAGE(PG8_SA(0, 1), cA + hstepA, voffA);
    if (wr == 1) PG8_BAR;
    PG8_WAIT_V(2); PG8_BAR;
    PG8_STAGE(PG8_SB(1, 0), cB + kstep, voffB); PG8_STAGE(PG8_SA(1, 0), cA + kstep, voffA); PG8_STAGE(PG8_SB(1, 1), cB + hstepB + kstep, voffB);
    PG8_WAIT_V(6); PG8_BAR;
    for (;;) {
        const bool has_next = S.next(ui + 1, nxt);
        const char* nA = has_next ? (const char*)g.aptr(nxt) : cA; const char* nB = has_next ? (const char*)g.bptr(nxt) : cB;
        for (int t = 0; t < nt; t += 2) {
            const bool last = (t == nt - 2);
            const char* a1 = cA + (size_t)(t + 1) * kstep;
            const char* a2 = last ? nA : cA + (size_t)(t + 2) * kstep; const char* b2 = last ? nB : cB + (size_t)(t + 2) * kstep;
            const char* a3 = a2 + kstep; const char* b3 = b2 + kstep;
            PG8_LDB(B0, 0, 0); PG8_LDB(B1, 0, 1); PG8_SCHED; PG8_LDA(At, 0, 0); PG8_STAGE(PG8_SA(1, 1), a1 + hstepA, voffA);
            PG8_WAIT_V(8); PG8_WAIT_L(0); PG8_BAR; PG8_MMA(0, 0, At, B0); PG8_MMA(0, 1, At, B1); PG8_BAR; PG8_SCHED;
            PG8_LDA(At, 0, 1); PG8_STAGE(PG8_SB(0, 0), b2, voffB); PG8_STAGE(PG8_SB(0, 1), b2 + hstepB, voffB); PG8_STAGE(PG8_SA(0, 0), a2, voffA);
            PG8_WAIT_V(8); PG8_WAIT_L(0); PG8_BAR; PG8_MMA(1, 0, At, B0); PG8_MMA(1, 1, At, B1); PG8_BAR; PG8_SCHED;
            PG8_LDB(B0, 1, 0); PG8_LDB(B1, 1, 1); PG8_SCHED; PG8_LDA(At, 1, 0); PG8_STAGE(PG8_SA(0, 1), a2 + hstepA, voffA);
            PG8_WAIT_V(8); PG8_WAIT_L(0); PG8_BAR; PG8_MMA(0, 0, At, B0); PG8_MMA(0, 1, At, B1); PG8_BAR; PG8_SCHED;
            PG8_LDA(At, 1, 1); PG8_STAGE(PG8_SB(1, 0), b3, voffB); PG8_STAGE(PG8_SB(1, 1), b3 + hstepB, voffB); PG8_STAGE(PG8_SA(1, 0), a3, voffA);
            PG8_WAIT_V(8); PG8_WAIT_L(0); PG8_BAR; PG8_MMA(1, 0, At, B0); PG8_MMA(1, 1, At, B1); PG8_BAR; PG8_SCHED;
        }
        if (wr == 0) PG8_BAR;
        if constexpr (DEFER) {   }
        else if constexpr (Epi::TILE) E.tile(acc, cur, wr, wc, fr, fq);
        else {
            const int row0 = cur.pm * BM + wr * 64 + fr, col0 = cur.pn * BM + wc * 32 + 4 * fq;
#pragma unroll
            for (int ai = 0; ai < 2; ++ai)
#pragma unroll
                for (int m = 0; m < 4; ++m)
#pragma unroll
                    for (int bj = 0; bj < 2; ++bj)
#pragma unroll
                        for (int n = 0; n < 2; ++n) E.put(cur, row0 + ai * HALF + m * 16, col0 + bj * HALF + n * 16, acc[ai][bj][m][n]);
        }
        if (!has_next) break;
#pragma unroll
        for (int a = 0; a < 2; ++a)
#pragma unroll
            for (int b = 0; b < 2; ++b)
#pragma unroll
                for (int m = 0; m < 4; ++m)
#pragma unroll
                    for (int n = 0; n < 2; ++n) acc[a][b][m][n] = (f32x4){0.f, 0.f, 0.f, 0.f};
        cur = nxt; cA = nA; cB = nB; ++ui;
        if (wr == 1) PG8_BAR;
    }
    PG8_WAIT_V(0);
    PG8_BAR;
#undef PG8_SA
#undef PG8_SB
#undef PG8_STAGE
#undef PG8_LDA
#undef PG8_LDB
#undef PG8_MMA
#undef PG8_WAIT_V
#undef PG8_WAIT_L
#undef PG8_BAR
#undef PG8_SCHED
}
template <class Epi, class Sched>
__device__ __forceinline__ void gemm_fast(LAS unsigned char* lds, const GemmP g, const Sched& S, const Epi& E) {
    f32x4 acc[2][2][4][2]; Unit cur;
    gemm_fast_core<Epi, Sched, false>(lds, g, S, E, acc, cur);
}
struct EpiNone { static constexpr bool TILE = false; __device__ __forceinline__ void put(const Unit&, int, int, f32x4) const {} };
__device__ __forceinline__ void tile_rowsq_publish(const f32x4 (&v)[2][2][4][2], const Unit& u, LAS unsigned char* lds, float* slots) {
    int tid = threadIdx.x; asm volatile("" : "+v"(tid));
    const int wid = __builtin_amdgcn_readfirstlane(tid >> 6), lane = tid & 63, wr = wid >> 2, wc = wid & 3, fr = lane & 15, fq = lane >> 4;
    LAS float* red = (LAS float*)lds;
#pragma unroll
    for (int ai = 0; ai < 2; ++ai)
#pragma unroll
        for (int m = 0; m < 4; ++m) { float sq = 0.f;
#pragma unroll
            for (int bj = 0; bj < 2; ++bj)
#pragma unroll
                for (int n = 0; n < 2; ++n) { const f32x4 x = v[ai][bj][m][n]; sq += (x[0] * x[0] + x[1] * x[1]) + (x[2] * x[2] + x[3] * x[3]); }
            sq += __shfl_xor(sq, 16); sq += __shfl_xor(sq, 32);
            if (fq == 0) red[(ai * HALF + wr * 64 + m * 16 + fr) * 4 + wc] = sq; }
    __syncthreads();
    if (tid < 256) { const f32x4 r = *(const LAS f32x4*)(red + tid * 4); slots[(size_t)(u.pm * BM + tid) * 8 + u.pn] = (r[0] + r[1]) + (r[2] + r[3]); }
}
__device__ __forceinline__ float row_rstd(const float* slots, int row) {
    const unsigned long long* sp = (const unsigned long long*)(slots + (size_t)row * 8); float t = 0.f;
#pragma unroll
    for (int q = 0; q < 4; ++q) { const unsigned long long w = __hip_atomic_load(sp + q, __ATOMIC_RELAXED, __HIP_MEMORY_SCOPE_AGENT); t += __uint_as_float((unsigned)w) + __uint_as_float((unsigned)(w >> 32)); }
    return rsqrtf(t * (1.0f / DM) + EPS);
}

template <class Epi, class Sched>
__device__ __forceinline__ void gemm_run(LAS unsigned char* lds, const GemmP g, const Sched& S, const Epi& E) {
#if GEMM_FAST
    gemm_fast(lds, g, S, E);
#else
    gemm_naive(g, S, E);
#endif
}


__device__ __forceinline__ f32x4 mma16(bf16x8 afrag, bf16x8 bfrag, f32x4 acc) { return __builtin_amdgcn_mfma_f32_16x16x32_bf16(bfrag, afrag, acc, 0, 0, 0); }
constexpr int GLA_NCH = 36;
template <int CTRL> __device__ __forceinline__ float dppz(float v) { return __int_as_float(__builtin_amdgcn_update_dpp(0, __float_as_int(v), CTRL, 0xf, 0xf, true)); }
#define LBAR() do { asm volatile("s_waitcnt lgkmcnt(0)" ::: "memory"); __builtin_amdgcn_s_barrier(); asm volatile("" ::: "memory"); } while (0)
__device__ __forceinline__ void gla_prep(LAS unsigned char* lds, int ufirst, int ucount, const bf16_t* Qb, const bf16_t* Kb, const bf16_t* Vb, const bf16_t* LR,
                                         const float* wgf, const float* bgf, const float* wgb, const float* bgb,
                                         bf16_t* KS, bf16_t* QD, bf16_t* VT, float* DEC, bf16_t* Of, bf16_t* Ob) {
    int tid = threadIdx.x; asm volatile("" : "+v"(tid));
    const int lane = tid & 63, wave = __builtin_amdgcn_readfirstlane(tid >> 6), fr = lane & 15, fq = lane >> 4;
    LAS bf16_t* qd = (LAS bf16_t*)lds; LAS bf16_t* kd = qd + 64 * 136; LAS bf16_t* sc = kd + 64 * 136; LAS bf16_t* vT = sc + 64 * 72;
    LAS bf16_t* ksT = vT + 256 * 72;
#pragma unroll 1
    for (int ui = 0; ui < ucount; ++ui) {
        const int unit = ufirst + ui;
        const int bh = unit / (2 * GLA_NCH), rem = unit % (2 * GLA_NCH), dir = rem / GLA_NCH, cidx = rem % GLA_NCH, b = bh >> 2, h = bh & 3;
        const bool lat = cidx >= 4;
        const int row0 = lat ? b * SEQ + (cidx - 4) * 64 : M + b * CTX + cidx * 64;
        const int kidx = (bh * 2 + dir) * GLA_NCH + cidx, qidx = (bh * 2 + dir) * 32 + (cidx - 4);
        const float* wsrc = dir ? wgb : wgf; const float* bsrc = dir ? bgb : bgf;
        LBAR();
        if (lat || dir == 0) {
#pragma unroll
            for (int j = 0; j < 4; ++j) { const int idx = tid + 512 * j, sp = idx & 63, c8 = (idx >> 6) * 8; const bf16x8 v = *(const bf16x8*)(Vb + (size_t)(row0 + sp) * VW + h * DV + c8);
#pragma unroll
                for (int e = 0; e < 8; ++e) vT[(c8 + e) * 72 + sp] = (bf16_t)v[e]; }
        }
        bf16x8 afr[4], bfr;
#pragma unroll
        for (int pt = 0; pt < 4; ++pt) afr[pt] = *(const bf16x8*)(LR + (size_t)(row0 + 16 * pt + fr) * 256 + dir * 16 + (fq & 1) * 8);
        { const float* wp = wsrc + (size_t)((fq & 1) * 8) * QKW + h * DK + 16 * wave + fr;
#pragma unroll
          for (int e = 0; e < 8; ++e) { const float wv = wp[e * QKW]; const unsigned hi = f2bfhw(wv); const float res = wv - bf2f((unsigned short)hi); bfr[e] = (short)(fq < 2 ? hi : f2bfhw(res)); } }
        const f32x4 bias4 = *(const f32x4*)(bsrc + h * DK + 16 * wave + 4 * fq);
        f32x4 k4[4], q4[4];
#pragma unroll
        for (int pt = 0; pt < 4; ++pt) { const size_t o = (size_t)(row0 + 16 * pt + fr) * QKW + h * DK + 16 * wave + 4 * fq; k4[pt] = ld_bf4(Kb + o); q4[pt] = lat ? ld_bf4(Qb + o) : (f32x4){0.f, 0.f, 0.f, 0.f}; }
        f32x4 la[4];
#pragma unroll
        for (int pt = 0; pt < 4; ++pt) { const f32x4 z = mma16(afr[pt], bfr, bias4);
#pragma unroll
            for (int i = 0; i < 4; ++i) { float x = (fminf(z[i], 0.f) - __logf(1.0f + __expf(-fabsf(z[i])))) * (1.0f / 16.0f);
                if (!dir) { x += dppz<0x111>(x); x += dppz<0x112>(x); x += dppz<0x114>(x); x += dppz<0x118>(x); }
                else      { x += dppz<0x101>(x); x += dppz<0x102>(x); x += dppz<0x104>(x); x += dppz<0x108>(x); }
                la[pt][i] = x; } }
        f32x4 carry = (f32x4){0.f, 0.f, 0.f, 0.f};
        if (!dir) {
#pragma unroll
            for (int pt = 0; pt < 4; ++pt) { f32x4 t;
#pragma unroll
                for (int i = 0; i < 4; ++i) t[i] = __shfl(la[pt][i], (lane & 48) | 15);
                la[pt] += carry; carry += t; }
        } else {
#pragma unroll
            for (int pt = 3; pt >= 0; --pt) { f32x4 t;
#pragma unroll
                for (int i = 0; i < 4; ++i) t[i] = __shfl(la[pt][i], lane & 48);
                la[pt] += carry; carry += t; }
        }
        const f32x4 blast = carry;
#pragma unroll
        for (int pt = 0; pt < 4; ++pt) { const int p = 16 * pt + fr;
            f32x4 ks, qn, kn;
#pragma unroll
            for (int i = 0; i < 4; ++i) { const float bv = la[pt][i]; ks[i] = k4[pt][i] * __expf(blast[i] - bv); qn[i] = q4[pt][i] * __expf(bv); kn[i] = k4[pt][i] * __expf(-bv); }
            const unsigned k01 = pk2hw(ks[0], ks[1]), k23 = pk2hw(ks[2], ks[3]);
            LAS bf16_t* kt = ksT + (16 * wave + 4 * fq) * 72 + p;
            kt[0] = (bf16_t)(k01 & 0xffffu); kt[72] = (bf16_t)(k01 >> 16); kt[144] = (bf16_t)(k23 & 0xffffu); kt[216] = (bf16_t)(k23 >> 16);
            if (lat) { u32x2 w; w.x = pk2hw(qn[0], qn[1]); w.y = pk2hw(qn[2], qn[3]); *(LAS u32x2*)(qd + p * 136 + 16 * wave + 4 * fq) = w;
                       w.x = pk2hw(kn[0], kn[1]); w.y = pk2hw(kn[2], kn[3]); *(LAS u32x2*)(kd + p * 136 + 16 * wave + 4 * fq) = w; } }
        if (fr == 0) { f32x4 dv; dv[0] = __expf(blast[0]); dv[1] = __expf(blast[1]); dv[2] = __expf(blast[2]); dv[3] = __expf(blast[3]); *(f32x4*)(DEC + kidx * 128 + 16 * wave + 4 * fq) = dv; }
        LBAR();
#pragma unroll
        for (int j = 0; j < 2; ++j) { const int idx = tid + 512 * j, dd = idx >> 3, part = idx & 7;
            *(u32x4*)(KS + (size_t)kidx * 8192 + ((((dd >> 4) * 2 + (part >> 2)) * 64 + (part & 3) * 16 + (dd & 15)) << 3)) = *(const LAS u32x4*)(ksT + dd * 72 + part * 8); }
        if (dir == 0) {
#pragma unroll
            for (int j = 0; j < 4; ++j) { const int idx = tid + 512 * j, v = idx >> 3, part = idx & 7;
                *(u32x4*)(VT + (size_t)(bh * GLA_NCH + cidx) * 16384 + ((((v >> 4) * 2 + (part >> 2)) * 64 + (part & 3) * 16 + (v & 15)) << 3)) = *(const LAS u32x4*)(vT + v * 72 + part * 8); }
        }
        if (lat) {
#pragma unroll
            for (int j = 0; j < 2; ++j) { const int idx = tid + 512 * j, pr = idx >> 4, part = idx & 15;
                *(u32x4*)(QD + (size_t)qidx * 8192 + ((((pr >> 4) * 4 + (part >> 2)) * 64 + (part & 3) * 16 + (pr & 15)) << 3)) = *(const LAS u32x4*)(qd + pr * 136 + part * 8); }
            { const int ct = wave >> 1; f32x4 acc[2] = {(f32x4){0.f, 0.f, 0.f, 0.f}, (f32x4){0.f, 0.f, 0.f, 0.f}};
#pragma unroll
                for (int k0 = 0; k0 < 4; ++k0) { const bf16x8 af = *(const LAS bf16x8*)(qd + (16 * ct + fr) * 136 + k0 * 32 + fq * 8);
#pragma unroll
                    for (int j = 0; j < 2; ++j) { const int st = (wave & 1) * 2 + j; const bf16x8 bf = *(const LAS bf16x8*)(kd + (16 * st + fr) * 136 + k0 * 32 + fq * 8); acc[j] = mma16(af, bf, acc[j]); } }
#pragma unroll
                for (int j = 0; j < 2; ++j) { const int st = (wave & 1) * 2 + j, c = 16 * ct + fr; f32x4 v = acc[j];
#pragma unroll
                    for (int i = 0; i < 4; ++i) { const int sp = 16 * st + 4 * fq + i; const bool keep = dir ? (sp >= c) : (sp <= c); v[i] = keep ? v[i] : 0.f; }
                    u32x2 w; w.x = pk2hw(v[0], v[1]); w.y = pk2hw(v[2], v[3]); *(LAS u32x2*)(sc + c * 72 + 16 * st + 4 * fq) = w; }
            }
            LBAR();
            { f32x4 acc[4][2];
#pragma unroll
                for (int ct = 0; ct < 4; ++ct) { acc[ct][0] = (f32x4){0.f, 0.f, 0.f, 0.f}; acc[ct][1] = (f32x4){0.f, 0.f, 0.f, 0.f}; }
#pragma unroll
                for (int k0 = 0; k0 < 2; ++k0) { bf16x8 bf[2];
#pragma unroll
                    for (int j = 0; j < 2; ++j) bf[j] = *(const LAS bf16x8*)(vT + (16 * (2 * wave + j) + fr) * 72 + k0 * 32 + fq * 8);
#pragma unroll
                    for (int ct = 0; ct < 4; ++ct) { const bf16x8 af = *(const LAS bf16x8*)(sc + (16 * ct + fr) * 72 + k0 * 32 + fq * 8);
                        acc[ct][0] = mma16(af, bf[0], acc[ct][0]); acc[ct][1] = mma16(af, bf[1], acc[ct][1]); } }
                bf16_t* O = dir ? Ob : Of;
#pragma unroll
                for (int ct = 0; ct < 4; ++ct)
#pragma unroll
                    for (int j = 0; j < 2; ++j) st_bf4(O + (((((((size_t)(b * 32 + cidx - 4) * 4 + h) * 8 + wave) * 4 + ct) * 2 + j) * 64 + lane) << 2), acc[ct][j]);
            }
        }
    }
    LBAR();
}
__device__ __forceinline__ void gla_scan(LAS unsigned char* lds, int bx, int G, const bf16_t* KS, const bf16_t* QD, const bf16_t* VT, const float* DEC, bf16_t* Of, bf16_t* Ob) {
    int tid = threadIdx.x; asm volatile("" : "+v"(tid));
    const int lane = tid & 63, wave = __builtin_amdgcn_readfirstlane(tid >> 6), fr = lane & 15, fq = lane >> 4;
    LAS bf16_t* ST = (LAS bf16_t*)lds;
    for (int unit = bx; unit < 256; unit += G) {
        const int vs = unit & 7, dir = (unit >> 3) & 1, bh = unit >> 4, b = bh >> 2, h = bh & 3;
        bf16_t* O = dir ? Ob : Of;
        f32x4 S0 = (f32x4){0.f, 0.f, 0.f, 0.f}, S1 = S0;
        const bf16x8 z8 = (bf16x8){0, 0, 0, 0, 0, 0, 0, 0};
#define GLB_DECL(P) bf16x8 P##ks0 = z8, P##ks1 = z8, P##v00 = z8, P##v01 = z8, P##v10 = z8, P##v11 = z8, P##q0 = z8, P##q1 = z8, P##q2 = z8, P##q3 = z8; float P##dec = 0.f; u32x2 P##oin = (u32x2){0u, 0u}; int P##row0 = 0;
        GLB_DECL(a_) GLB_DECL(b_) GLB_DECL(c_) GLB_DECL(d_)
#define GLB_LOAD(step_, P) do { const int st_ = (step_) < GLA_NCH ? (step_) : GLA_NCH - 1;     \
        const int cidx_ = st_ < 4 ? (dir ? 3 - st_ : st_) : (dir ? 39 - st_ : st_);                  \
        const int kidx_ = (bh * 2 + dir) * GLA_NCH + cidx_; const bf16_t* ksp_ = KS + (size_t)kidx_ * 8192 + ((wave * 2 * 64 + lane) << 3); \
        P##ks0 = *(const bf16x8*)ksp_; P##ks1 = *(const bf16x8*)(ksp_ + 512); \
        const bf16_t* vtp_ = VT + (size_t)(bh * GLA_NCH + cidx_) * 16384 + ((vs * 4 * 64 + lane) << 3); \
        P##v00 = *(const bf16x8*)vtp_; P##v01 = *(const bf16x8*)(vtp_ + 512); P##v10 = *(const bf16x8*)(vtp_ + 1024); P##v11 = *(const bf16x8*)(vtp_ + 1536); \
        P##dec = DEC[kidx_ * 128 + 16 * wave + fr]; \
        { const int lc_ = cidx_ >= 4 ? cidx_ - 4 : 0; const bf16_t* qp_ = QD + (size_t)((bh * 2 + dir) * 32 + lc_) * 8192 + (((wave >> 1) * 4 * 64 + lane) << 3); \
            P##q0 = *(const bf16x8*)qp_; P##q1 = *(const bf16x8*)(qp_ + 512); P##q2 = *(const bf16x8*)(qp_ + 1024); P##q3 = *(const bf16x8*)(qp_ + 1536); \
            P##row0 = lc_; \
            P##oin = *(const u32x2*)(O + (((((((size_t)(b * 32 + P##row0) * 4 + h) * 8 + vs) * 4 + (wave >> 1)) * 2 + (wave & 1)) * 64 + lane) << 2)); } } while (0)
#define GLB_STEP(step_, P, LAT_) do { const int sp_ = (step_); \
        if (LAT_) { const LAS bf16_t* stb = ST + ((sp_ - 1) & 1) * (32 * 136) + (16 * (wave & 1) + fr) * 136 + fq * 8; \
            f32x4 acc = (f32x4){0.f, 0.f, 0.f, 0.f}; \
            acc = mma16(P##q0, *(const LAS bf16x8*)(stb), acc); acc = mma16(P##q1, *(const LAS bf16x8*)(stb + 32), acc); \
            acc = mma16(P##q2, *(const LAS bf16x8*)(stb + 64), acc); acc = mma16(P##q3, *(const LAS bf16x8*)(stb + 96), acc); \
            const f32x4 oi_ = (f32x4){__uint_as_float(P##oin.x << 16), __uint_as_float(P##oin.x & 0xffff0000u), __uint_as_float(P##oin.y << 16), __uint_as_float(P##oin.y & 0xffff0000u)}; \
            st_bf4(O + (((((((size_t)(b * 32 + P##row0) * 4 + h) * 8 + vs) * 4 + (wave >> 1)) * 2 + (wave & 1)) * 64 + lane) << 2), oi_ + acc); } \
        S0 = S0 * P##dec; S1 = S1 * P##dec; \
        S0 = mma16(P##ks0, P##v00, S0); S0 = mma16(P##ks1, P##v01, S0); S1 = mma16(P##ks0, P##v10, S1); S1 = mma16(P##ks1, P##v11, S1); \
        { LAS bf16_t* stw = ST + (sp_ & 1) * (32 * 136) + 16 * wave + fr; \
          _Pragma("unroll") for (int i = 0; i < 4; ++i) { stw[(4 * fq + i) * 136] = (bf16_t)f2bfhw(S0[i]); stw[(16 + 4 * fq + i) * 136] = (bf16_t)f2bfhw(S1[i]); } } \
        asm volatile("s_waitcnt lgkmcnt(0)" ::: "memory"); __builtin_amdgcn_s_barrier(); asm volatile("" ::: "memory"); } while (0)
        __syncthreads();
        GLB_LOAD(0, a_); GLB_LOAD(1, b_); GLB_LOAD(2, c_);
        GLB_LOAD(3, d_); GLB_STEP(0, a_, false);
        GLB_LOAD(4, a_); GLB_STEP(1, b_, false);
        GLB_LOAD(5, b_); GLB_STEP(2, c_, false);
        GLB_LOAD(6, c_); GLB_STEP(3, d_, false);
#pragma unroll 1
        for (int step = 4; step < GLA_NCH; step += 4) {
            GLB_LOAD(step + 3, d_); GLB_STEP(step, a_, true);
            GLB_LOAD(step + 4, a_); GLB_STEP(step + 1, b_, true);
            GLB_LOAD(step + 5, b_); GLB_STEP(step + 2, c_, true);
            GLB_LOAD(step + 6, c_); GLB_STEP(step + 3, d_, true);
        }
#undef GLB_STEP
#undef GLB_DECL
#undef GLB_LOAD
    }
    __syncthreads();
}

#define XB_TMO      128
#define XB_XCNT(j)  (256  + 64 * (j))
#define XB_XSUB(j)  (1280 + 64 * (j))
#define XB_XGEN(j)  (2304 + 64 * (j))
#define XB_TOP      3328
#define XB_TOPGEN   3392
#define XCD_BAR_WORDS 3456
#define XB_SPIN_CAP (1u << 18)

__device__ __forceinline__ unsigned xb_ld(unsigned* p)              { return __hip_atomic_load(p, __ATOMIC_RELAXED, __HIP_MEMORY_SCOPE_AGENT); }
__device__ __forceinline__ unsigned xb_add(unsigned* p, unsigned v) { return __hip_atomic_fetch_add(p, v, __ATOMIC_RELAXED, __HIP_MEMORY_SCOPE_AGENT); }
__device__ __forceinline__ unsigned xb_xcc_id() { return (unsigned)__builtin_amdgcn_s_getreg((3 << 11) | 20) & 0xFu; }
#define XB_SPIN(cond, bar) do { unsigned _sp = 0; while (cond) { __builtin_amdgcn_s_sleep(1); \
    if ((++_sp & 255u) == 0u) { if (xb_ld(&(bar)[XB_TMO])) break; if (_sp > XB_SPIN_CAP) { atomicAdd(&(bar)[XB_TMO], 1u); break; } } } } while (0)

struct XcdBarrier {
    unsigned* bar; unsigned x;
    volatile LAS unsigned* st;
};

__device__ __forceinline__ XcdBarrier xcd_barrier_post(unsigned* bar, volatile LAS unsigned* st) {
    XcdBarrier b; b.bar = bar; b.x = xb_xcc_id(); b.st = st;
    if (threadIdx.x == 0) (void)xb_add(&bar[XB_XCNT(b.x)], 1u);
    return b;
}
__device__ __forceinline__ void xcd_barrier_complete(unsigned* bar, unsigned x, unsigned& nloc, unsigned& nx) {
    const unsigned G = gridDim.x * gridDim.y * gridDim.z;
    unsigned sum, cnt, mine, sp = 0u;
    for (;;) {
        sum = 0u; cnt = 0u; mine = 0u;
#pragma unroll
        for (unsigned j = 0; j < 16; ++j) { const unsigned c = xb_ld(&bar[XB_XCNT(j)]); sum += c; cnt += (c > 0u) ? 1u : 0u; mine = (j == x) ? c : mine; }
        if (sum == G) break;
        __builtin_amdgcn_s_sleep(1);
        if ((++sp & 255u) == 0u) { if (xb_ld(&bar[XB_TMO])) break; if (sp > XB_SPIN_CAP) { atomicAdd(&bar[XB_TMO], 1u); break; } }
    }
    nloc = mine > 0u ? mine : 1u; nx = cnt > 0u ? cnt : 1u;
}

__device__ __forceinline__ void xcd_barrier(const XcdBarrier& b) {
    asm volatile("s_waitcnt vmcnt(0)" ::: "memory");
    __syncthreads();
    if (threadIdx.x == 0) {
        unsigned* bar = b.bar;
        __builtin_amdgcn_s_waitcnt(0);
        unsigned nloc = b.st[0], nx = b.st[1];
        if (nloc == 0u) { xcd_barrier_complete(bar, b.x, nloc, nx); b.st[0] = nloc; b.st[1] = nx; }
        const unsigned old = xb_add(&bar[XB_XSUB(b.x)], 1u);
        const unsigned gen = old / nloc;
        if (old + 1u == (gen + 1u) * nloc) {
            __builtin_amdgcn_fence(__ATOMIC_RELEASE, "agent");
            asm volatile("s_waitcnt vmcnt(0)" ::: "memory");
            const unsigned og = xb_add(&bar[XB_TOP], 1u);
            const unsigned tg = og / nx;
            if (og + 1u == (tg + 1u) * nx) xb_add(&bar[XB_TOPGEN], 1u);
            else XB_SPIN(xb_ld(&bar[XB_TOPGEN]) == tg, bar);
            __builtin_amdgcn_fence(__ATOMIC_ACQUIRE, "agent");
            xb_add(&bar[XB_XGEN(b.x)], 1u);
            asm volatile("s_waitcnt vmcnt(0)" ::: "memory");
        } else {
            XB_SPIN(xb_ld(&bar[XB_XGEN(b.x)]) == gen, bar);
            __builtin_amdgcn_fence(__ATOMIC_ACQUIRE, "agent");
            asm volatile("s_waitcnt vmcnt(0)" ::: "memory");
        }
    }
    __syncthreads();
}
__device__ __forceinline__ void xcd_barrier_light(const XcdBarrier& b) {
    asm volatile("s_waitcnt vmcnt(0)" ::: "memory");
    __syncthreads();
    if (threadIdx.x == 0) {
        unsigned* bar = b.bar;
        __builtin_amdgcn_s_waitcnt(0);
        unsigned nloc = b.st[0], nx = b.st[1];
        if (nloc == 0u) { xcd_barrier_complete(bar, b.x, nloc, nx); b.st[0] = nloc; b.st[1] = nx; }
        const unsigned old = xb_add(&bar[XB_XSUB(b.x)], 1u);
        const unsigned gen = old / nloc;
        if (old + 1u == (gen + 1u) * nloc) {
            asm volatile("s_waitcnt vmcnt(0)" ::: "memory");
            const unsigned og = xb_add(&bar[XB_TOP], 1u);
            const unsigned tg = og / nx;
            if (og + 1u == (tg + 1u) * nx) xb_add(&bar[XB_TOPGEN], 1u);
            else XB_SPIN(xb_ld(&bar[XB_TOPGEN]) == tg, bar);
            xb_add(&bar[XB_XGEN(b.x)], 1u);
            asm volatile("s_waitcnt vmcnt(0)" ::: "memory");
        } else {
            XB_SPIN(xb_ld(&bar[XB_XGEN(b.x)]) == gen, bar);
            asm volatile("s_waitcnt vmcnt(0)" ::: "memory");
        }
    }
    __syncthreads();
}

__device__ __forceinline__ void transpose_item(const float* W, int K, int N, bf16_t* WT, int drow0, LAS float* scr, int k0, int n0, int lane) {
#pragma unroll 8
    for (int i = 0; i < 32; ++i) { const int kk = 2 * i + (lane >> 5); scr[kk * 33 + (lane & 31)] = W[(size_t)(k0 + kk) * N + n0 + (lane & 31)]; }
    asm volatile("s_waitcnt lgkmcnt(0)" ::: "memory");
    const int c = lane & 7;
#pragma unroll
    for (int j = 0; j < 4; ++j) { const int n = (lane >> 3) + 8 * j; const LAS float* s = scr + (8 * c) * 33 + n;
        u32x4 o; o.x = pk2(s[0 * 33], s[1 * 33]); o.y = pk2(s[2 * 33], s[3 * 33]); o.z = pk2(s[4 * 33], s[5 * 33]); o.w = pk2(s[6 * 33], s[7 * 33]);
        *(u32x4*)(WT + (size_t)(drow0 + n) * K + k0 + 8 * c) = o; }
    asm volatile("s_waitcnt lgkmcnt(0)" ::: "memory");
}

template <int MODOFF, int STORE  , bool BASE_BF16>
__device__ __forceinline__ void epi_rows_part1(LAS unsigned char* lds, const f32x4 (&acc)[2][2][4][2], const Unit& u, const float* base, const float* mod, float* outp, float* slots, f32x4 (&xr)[2][16]) {
    int tid = threadIdx.x; asm volatile("" : "+v"(tid));
    const int wid = __builtin_amdgcn_readfirstlane(tid >> 6), lane = tid & 63, wr = wid >> 2, wc = wid & 3, fr = lane & 15, fq = lane >> 4;
    LAS float* T = (LAS float*)lds;
    const int colg = u.pn * BM + 4 * lane;
    const f32x4 gt = *(const f32x4*)(mod + ((u.pm * BM) >> 11) * MODW + MODOFF * DM + colg);
#pragma unroll
    for (int ai = 0; ai < 2; ++ai) {
        if (ai) LBAR();
#pragma unroll
        for (int m = 0; m < 4; ++m)
#pragma unroll
            for (int bj = 0; bj < 2; ++bj)
#pragma unroll
                for (int n = 0; n < 2; ++n) { const int rl = wr * 64 + m * 16 + fr, c4 = (bj * HALF + wc * 32 + n * 16 + 4 * fq) >> 2;
                    *(LAS f32x4*)(T + rl * 256 + ((c4 ^ (rl & 15)) << 2)) = acc[ai][bj][m][n]; }
        LBAR();
#pragma unroll
        for (int j = 0; j < 16; ++j) { const int rl = wid * 16 + j, row = u.pm * BM + ai * HALF + rl; const size_t o = (size_t)row * DM + colg;
            const f32x4 v = *(const LAS f32x4*)(T + rl * 256 + ((lane ^ j) << 2));
            const f32x4 bs = BASE_BF16 ? ld_bf4((const bf16_t*)base + o) : *(const f32x4*)(base + o);
            const f32x4 x1 = bs + gt * v; xr[ai][j] = x1; if (STORE == 2) st_bf4((bf16_t*)outp + o, x1);
            const float sq = wave_sum((x1[0] * x1[0] + x1[1] * x1[1]) + (x1[2] * x1[2] + x1[3] * x1[3]));
            if (lane == 0) __hip_atomic_store((unsigned*)slots + (size_t)row * 8 + u.pn, __float_as_uint(sq), __ATOMIC_RELAXED, __HIP_MEMORY_SCOPE_AGENT); }
    }
}

struct Args { const float* in[N_IN]; float* out; unsigned char* ws; };

__global__ void __launch_bounds__(NTHR, 2) fwd_kernel(Args a) {
    extern __shared__ __attribute__((aligned(16))) unsigned char lds_raw[];
    LAS unsigned char* lds = (LAS unsigned char*)lds_raw;
    cg::grid_group grid = cg::this_grid();
    const int G = gridDim.x, bx = blockIdx.x, NGW = G * 8, NT = G * NTHR;
    if (threadIdx.x < 64) ((LAS unsigned*)(lds + 131072))[threadIdx.x] = 0u;
    if (bx == 0) for (int i = threadIdx.x; i < XCD_BAR_WORDS; i += NTHR) __hip_atomic_store((unsigned*)(a.ws + 16384) + i, 0u, __ATOMIC_RELAXED, __HIP_MEMORY_SCOPE_AGENT);
    __syncthreads();
    grid.sync();
    const XcdBarrier xbar = xcd_barrier_post((unsigned*)(a.ws + 16384), (volatile LAS unsigned*)(lds + 131072 + 32));
#define GRID_BAR() xcd_barrier(xbar)
#define PHASE_IDS int tid = threadIdx.x; asm volatile("" : "+v"(tid)); const int lane = tid & 63, wave = __builtin_amdgcn_readfirstlane(tid >> 6), gw = bx * 8 + wave, gtid = bx * NTHR + tid; (void)lane; (void)gw; (void)gtid;
    unsigned char* ws = a.ws;
    float* mod = (float*)(ws + OFF_MOD);
    bf16_t* WinT = (bf16_t*)(ws + OFF_WIN); bf16_t* WglaT = (bf16_t*)(ws + OFF_WGLA); bf16_t* WfnT = (bf16_t*)(ws + OFF_WFN); bf16_t* WoT = (bf16_t*)(ws + OFF_WO);
    bf16_t* WupT = (bf16_t*)(ws + OFF_WUP); bf16_t* WdT = (bf16_t*)(ws + OFF_WD); bf16_t* DT = (bf16_t*)(ws + OFF_DT); bf16_t* CS = (bf16_t*)(ws + OFF_CS);
    bf16_t* H1 = (bf16_t*)(ws + OFF_A); bf16_t* XT = H1; bf16_t* Y = H1; bf16_t* H2 = H1;
    bf16_t* Qb = (bf16_t*)(ws + OFF_Q); bf16_t* Kb = (bf16_t*)(ws + OFF_K); bf16_t* Vb = (bf16_t*)(ws + OFF_V); bf16_t* Rb = (bf16_t*)(ws + OFF_R);
    bf16_t* Fb = (bf16_t*)(ws + OFF_F); bf16_t* GA = (bf16_t*)(ws + OFF_GA); bf16_t* GB = (bf16_t*)(ws + OFF_GB); bf16_t* LR = (bf16_t*)(ws + OFF_LR);
    bf16_t* Ff = (bf16_t*)(ws + OFF_FF); bf16_t* Of = (bf16_t*)(ws + OFF_OF); bf16_t* Ob = (bf16_t*)(ws + OFF_OB);
    bf16_t* AG = Qb; bf16_t* U = (bf16_t*)(ws + OFF_U); bf16_t* ACT = (bf16_t*)(ws + OFF_ACT);
    float* out = a.out;

    {
        PHASE_IDS
        LAS float* scr = (LAS float*)(lds + wave * 16384);
        constexpr int IT_IN = 32 * 257, IT_GLA = 16 * 64, IT_FN = 16 * 64, IT_OUT = 32 * 64;
        (void)IT_GLA; (void)IT_FN; (void)IT_OUT;
        for (int it = gw; it < IT_IN; it += NGW) {
            const int r = it, kb = r / 257, nb = r % 257, n0 = nb * 32; const int d0 = n0 < 3072 ? n0 : (n0 == 3072 ? 8192 : n0 - 32);
            transpose_item(a.in[I_WIN], DM, INW, WinT, d0, scr, kb * 64, n0, lane);
        }
        for (int i = gtid; i < 224 * 256; i += NT) ((u32x4*)(WinT + (size_t)8224 * DM))[i] = (u32x4){0u, 0u, 0u, 0u};
        for (int gi = gtid; gi < 2048 * 512; gi += NT) {
            const int k1 = gi >> 9, j0 = (gi & 511) * 8; float v[8];
#pragma unroll
            for (int e = 0; e < 8; ++e) { const int j = j0 + e; const int ph = (k1 * (j & 2047)) & 2047; const float x = (float)ph * (1.0f / 1024.0f); v[e] = j < 2048 ? cospif(x) : -sinpif(x); }
            u32x4 o; o.x = pk2(v[0], v[1]); o.y = pk2(v[2], v[3]); o.z = pk2(v[4], v[5]); o.w = pk2(v[6], v[7]);
            *(u32x4*)(DT + (size_t)k1 * 4096 + j0) = o;
        }
        for (int gi = gtid; gi < 512 * 32; gi += NT) {
            const int m = gi >> 5, c0 = (gi & 31) * 8; float v[8];
#pragma unroll
            for (int e = 0; e < 8; ++e) { const int ph = ((m & 255) * (c0 + e)) & 255; const float x = (float)ph * (1.0f / 128.0f); v[e] = (m < 256 ? cospif(x) : sinpif(x)) * 0.0625f; }
            u32x4 o; o.x = pk2(v[0], v[1]); o.y = pk2(v[2], v[3]); o.z = pk2(v[4], v[5]); o.w = pk2(v[6], v[7]);
            *(u32x4*)(CS + (size_t)m * 256 + c0) = o;
        }
    }
    {
        PHASE_IDS
        LAS float* sl = (LAS float*)lds;
        LAS float* red = sl + 5 * DM;
        __syncthreads();
        for (int i = tid; i < 5 * DM; i += NTHR) { const float c = i < 4 * DM ? a.in[I_C][i] : a.in[I_CCTX][i - 4 * DM]; sl[i] = c * sigmoidf_(c); }
        __syncthreads();
        for (int cb = bx; cb < 256; cb += G) {
            const int col = cb * 48 + (lane < 48 ? lane : 47);
            float acc[5] = {0.f, 0.f, 0.f, 0.f, 0.f};
            const float* wp = a.in[I_WADA] + (size_t)(wave * 256) * MODW + col;
#pragma unroll 16
            for (int kk = 0; kk < 256; ++kk) {
                const float w = wp[(size_t)kk * MODW];
#pragma unroll
                for (int r = 0; r < 5; ++r) acc[r] += w * sl[r * DM + wave * 256 + kk];
            }
            if (lane < 48) {
#pragma unroll
                for (int r = 0; r < 5; ++r) red[(wave * 5 + r) * 48 + lane] = acc[r];
            }
            __syncthreads();
            if (tid < 240) { const int r = tid / 48, c = tid % 48; float s = a.in[I_BADA][cb * 48 + c];
#pragma unroll
                for (int w = 0; w < 8; ++w) s += red[(w * 5 + r) * 48 + c];
                mod[r * MODW + cb * 48 + c] = s; }
            __syncthreads();
        }
    }
    GRID_BAR();

    { PHASE_IDS
    for (int m = gw; m < MT; m += NGW) {
        const float* src = m < M ? a.in[I_X] + (size_t)m * DM : a.in[I_CTX] + (size_t)(m - M) * DM;
        const float* md = mod + (m < M ? (m >> 11) : 4) * MODW;
        f32x4 v[8]; float ss = 0.f;
#pragma unroll
        for (int j = 0; j < 8; ++j) { v[j] = *(const f32x4*)(src + j * 256 + lane * 4); ss += (v[j][0] * v[j][0] + v[j][1] * v[j][1]) + (v[j][2] * v[j][2] + v[j][3] * v[j][3]); }
        const float rstd = rsqrtf(wave_sum(ss) * (1.0f / DM) + EPS);
#pragma unroll
        for (int j = 0; j < 8; ++j) { const int c = j * 256 + lane * 4;
            const f32x4 g = *(const f32x4*)(a.in[I_G1] + c), sh = *(const f32x4*)(md + c), sc = *(const f32x4*)(md + DM + c);
            st_bf4(H1 + (size_t)m * DM + c, (v[j] * rstd * g) * (sc + 1.0f) + sh); }
    } }
    GRID_BAR();

    {
        GemmP g{H1, WinT, DM, DM, DM, 0, 0}; SchedProj S; S.g = SchedGrid{32, 33, 32, G, bx};
        EpiProj E{Qb, Kb, Vb, Rb, Fb, GA, GB, LR};
        gemm_run(lds, g, S, E);
    }
    {
        constexpr int LASTR = 32 * 33 + 28 - 1024;
        const int first = (G == 256) ? LASTR : 0;
        if (bx >= first) {
            PHASE_IDS
            LAS float* scr = (LAS float*)(lds + wave * 16384);
            constexpr int IT_UP = 32 * 352, IT_DN = 88 * 64;
            const int gw2 = (bx - first) * 8 + wave, NGW2 = (G - first) * 8;
            constexpr int IT_GLA = 16 * 64, IT_FN = 16 * 64, IT_OUT = 32 * 64;
            for (int it = gw2; it < IT_UP + IT_GLA + IT_FN + IT_OUT; it += NGW2) {
                int r = it;
                if (r >= IT_UP) { r -= IT_UP;
                    if (r < IT_GLA) { transpose_item(a.in[I_WGLA], VW, DM, WglaT, (r % 64) * 32, scr, (r / 64) * 64, (r % 64) * 32, lane); continue; } r -= IT_GLA;
                    if (r < IT_FN) { transpose_item(a.in[I_WFN], FNW, DM, WfnT, (r % 64) * 32, scr, (r / 64) * 64, (r % 64) * 32, lane); continue; } r -= IT_FN;
                    transpose_item(a.in[I_WOUT], DM, DM, WoT, (r % 64) * 32, scr, (r / 64) * 64, (r % 64) * 32, lane); continue; }
                if (r < IT_UP) { const int n0 = (r % 352) * 32, j = n0 < FF ? n0 : n0 - FF; transpose_item(a.in[I_WUP], DM, F2, WupT, (j >> 7) * 256 + (n0 < FF ? 0 : 128) + (j & 127), scr, (r / 352) * 64, n0, lane); continue; } r -= IT_UP;
                transpose_item(a.in[I_WDN], FF, DM, WdT, (r % 64) * 32, scr, (r / 64) * 64, (r % 64) * 32, lane);
            }
        }
    }
    GRID_BAR();

    {
        GemmP g{CS, Fb, 256, FNW, 256, (long)SEQ * FNW, 256}; SchedGrid S{32, 8, 2, G, bx};
        EpiFn1 E{XT};
        gemm_run(lds, g, S, E);
    }
    GRID_BAR();
    bf16_t* KS = (bf16_t*)out; bf16_t* QD = (bf16_t*)((unsigned char*)out + 18 * MiB); bf16_t* VT = (bf16_t*)((unsigned char*)out + 34 * MiB); float* DEC = (float*)((unsigned char*)out + 52 * MiB);
    if (((bx >> 3) & 3) == 0) {
        const int fj = (bx >> 5) * 8 + (bx & 7);
        { GemmP g{DT, XT, 4096, 4096, 4096, (long)4 * 256 * 4096, (long)256 * 4096}; SchedGrid S{64, 1, 4, 64, fj};
          EpiFn2S E{Ff, 0.02209708691207961f};
          gemm_fast(lds, g, S, E); }
    } else {
        const int gj = (bx >> 5) * 24 + (bx & 31) - 8;
        gla_prep(lds, gj * 6, 6, Qb, Kb, Vb, LR, a.in[I_WGF], a.in[I_BGF], a.in[I_WGB], a.in[I_BGB], KS, QD, VT, DEC, Of, Ob);
    }
    GRID_BAR();
    gla_scan(lds, ((bx & 7) * 4 + (bx >> 6)) * 8 + ((bx >> 3) & 7), G, KS, QD, VT, DEC, Of, Ob);
    GRID_BAR();
    { PHASE_IDS
      for (int task = gw; task < NB * 1023; task += NGW) { const int b = task / 1023, row = 1 + task % 1023;
          const bf16_t* src = Ff + (size_t)(b * SEQ + row) * FNW; bf16_t* dst = Ff + (size_t)(b * SEQ + SEQ - row) * FNW;
#pragma unroll
          for (int g = 0; g < 4; ++g) { const bf16_t* sg = src + g * 256; const int c = 4 * lane;
              const unsigned e0 = sg[(256 - c) & 255], e1 = sg[255 - c], e2 = sg[254 - c], e3 = sg[253 - c];
              u32x2 w; w.x = e0 | (e1 << 16); w.y = e2 | (e3 << 16); *(u32x2*)(dst + g * 256 + c) = w; } }
      for (int task = gw; task < 16 * 256; task += NGW) { const int bz = task >> 8, ch = task & 255;
          const bf16_t* xp = XT + (size_t)bz * 256 * 4096 + (size_t)ch * 4096; float sacc = 0.f;
#pragma unroll
          for (int it = 0; it < 4; ++it) { const bf16x8 xv = *(const bf16x8*)(xp + it * 512 + lane * 8);
#pragma unroll
              for (int e = 0; e < 8; e += 2) sacc += bf2f((unsigned short)xv[e]) - bf2f((unsigned short)xv[e + 1]); }
          sacc = wave_sum(sacc);
          if (lane == 0) Ff[(size_t)((bz >> 2) * SEQ + 1024) * FNW + (bz & 3) * 256 + ch] = (bf16_t)f2bfhw(sacc * 0.02209708691207961f); } }
    { PHASE_IDS
    for (int task = gw; task < NB * 32 * 4 * NH; task += NGW) { const int h = task & 3, ct = (task >> 2) & 3, n = (task >> 4) & 31, b = task >> 9, fr = lane & 15, fq = lane >> 4;
        f32x4 ov[16]; float ss = 0.f;
#pragma unroll
        for (int t = 0; t < 16; ++t) { const size_t o = ((((((size_t)(b * 32 + n) * 4 + h) * 8 + (t >> 1)) * 4 + ct) * 2 + (t & 1)) * 64 + lane) << 2;
            const f32x4 x = ld_bf4(Of + o) + ld_bf4(Ob + o); ov[t] = x; ss += (x[0] * x[0] + x[1] * x[1]) + (x[2] * x[2] + x[3] * x[3]); }
        ss += __shfl_xor(ss, 16); ss += __shfl_xor(ss, 32);
        const float rstd = rsqrtf(ss * (1.0f / DV) + EPS);
        const size_t ro = (size_t)(b * SEQ + n * 64 + 16 * ct + fr) * VW + h * DV + 4 * fq;
#pragma unroll
        for (int t = 0; t < 16; ++t) { const f32x4 gg = *(const f32x4*)(a.in[I_GGLA] + h * DV + t * 16 + 4 * fq);
            st_bf4(AG + ro + t * 16, ld_bf4(Rb + ro + t * 16) * (ov[t] * rstd * gg)); }
    } }
    GRID_BAR();

    {
        GemmP g{AG, WglaT, VW, VW, VW, 0, (long)((OFF_WFN - OFF_WGLA) / 2), (long)((OFF_FF - OFF_Q) / 2)}; SchedPair S; S.g = SchedGrid{32, 8, 32, G, bx};
        EpiYab E{GA, GB, out, Y};
        gemm_fast(lds, g, S, E);
    }
    GRID_BAR();
    float* slots1 = (float*)(ws + 320 * 1024); float* slots2 = (float*)(ws + 576 * 1024);
    {
        f32x4 xr[2][16]; Unit u;
        { f32x4 acc[2][2][4][2];
          { GemmP g{Y, WoT, DM, DM, DM, 0, 0}; SchedGrid S{32, 8, 32, G, bx}; gemm_fast_core<EpiNone, SchedGrid, true>(lds, g, S, EpiNone{}, acc, u); }
          epi_rows_part1<2, 2, false>(lds, acc, u, a.in[I_X], mod, out, slots1, xr); }
        xcd_barrier_light(xbar);
        int tid2 = threadIdx.x; asm volatile("" : "+v"(tid2));
        { const int wid2 = __builtin_amdgcn_readfirstlane(tid2 >> 6), colg = u.pn * BM + 4 * (tid2 & 63); const float* md = mod + ((u.pm * BM) >> 11) * MODW;
          const f32x4 gg = *(const f32x4*)(a.in[I_G2] + colg), sh = *(const f32x4*)(md + 3 * DM + colg), sc = *(const f32x4*)(md + 4 * DM + colg) + 1.0f;
#pragma unroll
          for (int ai = 0; ai < 2; ++ai)
#pragma unroll
              for (int j = 0; j < 16; ++j) { const int row = u.pm * BM + ai * HALF + wid2 * 16 + j; const float rstd = row_rstd(slots1, row);
                  st_bf4(H2 + (size_t)row * DM + colg, (xr[ai][j] * rstd * gg) * sc + sh); }
        }
    }
    GRID_BAR();
    {
        GemmP g{H2, WupT, DM, DM, DM, 0, 0}; SchedGrid S{32, 44, 32, G, bx};
        EpiUpConv E{a.in[I_CW], a.in[I_CB], ACT};
#if GEMM_FAST
        gemm_fast(lds, g, S, E);
#endif
    }
    if (bx >= 128) {
        PHASE_IDS
        LAS float* scr = (LAS float*)(lds + wave * 16384);
        for (int r = (bx - 128) * 8 + wave; r < 88 * 64; r += (G - 128) * 8)
            transpose_item(a.in[I_WDN], FF, DM, WdT, (r % 64) * 32, scr, (r / 64) * 64, (r % 64) * 32, lane);
    }
    GRID_BAR();
    {
        f32x4 xr[2][16]; Unit u;
        { f32x4 acc[2][2][4][2];
          { GemmP g{ACT, WdT, FF, FF, FF, 0, 0}; SchedGrid S{32, 8, 32, G, bx}; gemm_fast_core<EpiNone, SchedGrid, true>(lds, g, S, EpiNone{}, acc, u); }
          epi_rows_part1<5, 0, true>(lds, acc, u, out, mod, out, slots2, xr); }
        xcd_barrier_light(xbar);
        int tid2 = threadIdx.x; asm volatile("" : "+v"(tid2));
        { const int wid2 = __builtin_amdgcn_readfirstlane(tid2 >> 6), colg = u.pn * BM + 4 * (tid2 & 63);
          const f32x4 gf = *(const f32x4*)(a.in[I_GF] + colg);
#pragma unroll
          for (int ai = 0; ai < 2; ++ai)
#pragma unroll
              for (int j = 0; j < 16; ++j) { const int row = u.pm * BM + ai * HALF + wid2 * 16 + j; const float rstd = row_rstd(slots2, row);
                  *(f32x4*)(out + (size_t)row * DM + colg) = xr[ai][j] * rstd * gf; }
        }
    }
}

extern "C" void kernel_launch(void* const* d_in, const int* in_sizes, int n_in, void* d_out, int out_size, void* d_ws, size_t ws_size, hipStream_t stream) {
    static int grid = 0;
    if (grid == 0) {
        if (n_in != N_IN || out_size != M * DM || ws_size < WS_END) { fprintf(stderr, "kernel_launch: unexpected shapes: n_in %d out %d ws %zu (need %zu)\n", n_in, out_size, ws_size, (size_t)WS_END); grid = -1; return; }
        int dev = 0, cus = 0, per_cu = 0;
        (void)hipGetDevice(&dev);
        (void)hipDeviceGetAttribute(&cus, hipDeviceAttributeMultiprocessorCount, dev);
        if (hipFuncSetAttribute((const void*)fwd_kernel, hipFuncAttributeMaxDynamicSharedMemorySize, LDS_BYTES) != hipSuccess) { fprintf(stderr, "kernel_launch: hipFuncSetAttribute failed\n"); grid = -1; return; }
        (void)hipOccupancyMaxActiveBlocksPerMultiprocessor(&per_cu, (const void*)fwd_kernel, NTHR, LDS_BYTES);
        if (per_cu < 1) { fprintf(stderr, "kernel_launch: occupancy query reports %d blocks per CU\n", per_cu); grid = -1; return; }
        if (cus != 256) { fprintf(stderr, "kernel_launch: built for a 256-CU device (one 256x256 unit per workgroup in the fused-norm GEMM phases), got %d\n", cus); grid = -1; return; }
        grid = cus;
    }
    if (grid < 0) return;
    Args a{};
    for (int i = 0; i < N_IN; ++i) a.in[i] = (const float*)d_in[i];
    a.out = (float*)d_out; a.ws = (unsigned char*)d_ws;
    void* args[] = {&a};
    hipError_t e = hipLaunchCooperativeKernel((const void*)fwd_kernel, dim3(grid), dim3(NTHR), args, LDS_BYTES, stream);
    if (e != hipSuccess) fprintf(stderr, "kernel_launch: cooperative launch failed: %s (grid %d)\n", hipGetErrorString(e), grid);
}
```

```cpp
#include <hip/hip_runtime.h>
#include <hip/hip_cooperative_groups.h>
#include <cstdio>
#include <cstdint>
namespace cg = cooperative_groups;

#ifndef GEMM_FAST
#define GEMM_FAST 1
#endif

#define LAS __attribute__((address_space(3)))
typedef unsigned short bf16_t;
typedef short bf16x8 __attribute__((ext_vector_type(8)));
typedef float f32x4 __attribute__((ext_vector_type(4)));
typedef unsigned u32x4 __attribute__((ext_vector_type(4)));
typedef unsigned u32x2 __attribute__((ext_vector_type(2)));

constexpr int DM = 2048, NB = 4, SEQ = 2048, M = NB * SEQ, CTX = 256, MC = NB * CTX, MT = M + MC;
constexpr int NH = 4, DK = 128, DV = 256, RANK = 16, FF = 5632, F2 = 2 * FF, INW = 8224, NPROJ = 8448;
constexpr int QKW = 512, VW = 1024, FNW = 1024, MODW = 6 * DM;
constexpr float EPS = 1e-6f;
enum { I_X = 0, I_C, I_CTX, I_CCTX, I_WADA, I_BADA, I_G1, I_WIN, I_WGF, I_BGF, I_WGB, I_BGB, I_GGLA, I_WGLA, I_WFN, I_WOUT, I_G2, I_WUP, I_CW, I_CB, I_WDN, I_GF, N_IN };

constexpr size_t MiB = 1u << 20;
constexpr size_t CTL_ZERO_BYTES = 1 * MiB;
constexpr size_t OFF_MOD = 65536;
constexpr size_t OFF_WIN = 1 * MiB;
constexpr size_t OFF_WGLA = 34 * MiB;
constexpr size_t OFF_WFN = 38 * MiB;
constexpr size_t OFF_WO = 42 * MiB;
constexpr size_t OFF_WUP = 50 * MiB;
constexpr size_t OFF_WD = 94 * MiB;
constexpr size_t OFF_DT = 116 * MiB;
constexpr size_t OFF_CS = 132 * MiB;
constexpr size_t OFF_A = 133 * MiB;
constexpr size_t OFF_Q = 169 * MiB;
constexpr size_t OFF_K = 177 * MiB;
constexpr size_t OFF_V = 186 * MiB;
constexpr size_t OFF_R = 204 * MiB;
constexpr size_t OFF_F = 220 * MiB;
constexpr size_t OFF_GA = 236 * MiB;
constexpr size_t OFF_GB = 268 * MiB;
constexpr size_t OFF_LR = 300 * MiB;
constexpr size_t OFF_FF = 305 * MiB;
constexpr size_t OFF_OF = 321 * MiB;
constexpr size_t OFF_OB = 353 * MiB;
constexpr size_t WS_END = 385 * MiB;
constexpr size_t OFF_U = 169 * MiB;
constexpr size_t OFF_ACT = 257 * MiB;

constexpr int LDS_BYTES = 147456;
constexpr int NTHR = 512;

__device__ __forceinline__ float bf2f(unsigned short h) { return __uint_as_float((unsigned)h << 16); }
__device__ __forceinline__ unsigned f2bf(float f) { unsigned u = __float_as_uint(f); return (u + 0x7fffu + ((u >> 16) & 1u)) >> 16; }
typedef __bf16 bf16v2_t __attribute__((ext_vector_type(2)));
__device__ __forceinline__ unsigned pk2hw(float lo, float hi) { bf16v2_t v; v[0] = (__bf16)lo; v[1] = (__bf16)hi; return __builtin_bit_cast(unsigned, v); }
__device__ __forceinline__ unsigned pk2(float lo, float hi) { return pk2hw(lo, hi); }
__device__ __forceinline__ unsigned f2bfhw(float f) { return (unsigned)__builtin_bit_cast(unsigned short, (__bf16)f); }
__device__ __forceinline__ f32x4 ld_bf4(const bf16_t* p) { u32x2 w = *(const u32x2*)p; return (f32x4){__uint_as_float(w.x << 16), __uint_as_float(w.x & 0xffff0000u), __uint_as_float(w.y << 16), __uint_as_float(w.y & 0xffff0000u)}; }
__device__ __forceinline__ void st_bf4(bf16_t* p, f32x4 v) { u32x2 w; w.x = pk2(v[0], v[1]); w.y = pk2(v[2], v[3]); *(u32x2*)p = w; }
__device__ __forceinline__ float sigmoidf_(float x) { return __builtin_amdgcn_rcpf(1.f + __expf(-x)); }
__device__ __forceinline__ float wave_sum(float v) {
#pragma unroll
    for (int o = 1; o < 64; o <<= 1) v += __shfl_xor(v, o);
    return v;
}

constexpr int BM = 256, BK = 64, HALF = 128, HTB = HALF * BK * 2, NXCD = 8, WGM = 8;
struct Unit { int pm, pn, bz; };
struct GemmP {
    const bf16_t* A; const bf16_t* Bt; int lda, ldb, K; long sB1, sB2, sA2;
    __device__ __forceinline__ const bf16_t* aptr(const Unit& u) const { return A + (size_t)(u.bz & 3) * sA2 + (size_t)u.pm * BM * lda; }
    __device__ __forceinline__ const bf16_t* bptr(const Unit& u) const { return Bt + (size_t)(u.bz >> 2) * sB1 + (size_t)(u.bz & 3) * sB2 + (size_t)u.pn * BM * ldb; }
};
struct SchedGrid {
    int nMt, nN, nMb, G, c;
    __device__ __forceinline__ bool decode(int L, Unit& u) const {
        const int nwg = nMt * nN; if (L >= nwg) return false;
        int wgid = L; { const int q = nwg / NXCD, r = nwg % NXCD, xcd = wgid % NXCD, off = wgid / NXCD; wgid = (xcd < r ? xcd * (q + 1) : r * (q + 1) + (xcd - r) * q) + off; }
        const int nig = WGM * nN, gid = wgid / nig, fm = gid * WGM, gsz = (nMt - fm) < WGM ? (nMt - fm) : WGM;
        const int pmt = fm + ((wgid % nig) % gsz); u.pn = (wgid % nig) / gsz; u.bz = pmt / nMb; u.pm = pmt % nMb; return true;
    }
    __device__ __forceinline__ bool next(int i, Unit& u) const { return decode(i * G + c, u); }
};
struct SchedProj {
    SchedGrid g;
    __device__ __forceinline__ bool next(int i, Unit& u) const {
        const int L = i * g.G + g.c;
        if (L < 32 * 33) return g.decode(L, u);
        const int j = L - 32 * 33; if (j >= 28) return false;
        const int t = j >> 2; u.pm = 32 + (j & 3); u.pn = t < 6 ? t + 2 : 32; u.bz = 0; return true;
    }
};

struct EpiProj { static constexpr bool TILE = false;
    bf16_t *Q, *Kb, *Vb, *R, *F, *GA, *GB, *LR;
    __device__ __forceinline__ void put(const Unit& u, int row, int col, f32x4 v) const {
        const int pn = u.pn; bf16_t* base; int ldc, c0, act = 0;
        if (pn < 2) { base = Q; ldc = 512; c0 = 0; act = 1; }
        else if (pn < 4) { base = Kb; ldc = 512; c0 = 512; }
        else if (pn < 8) { base = Vb; ldc = 1024; c0 = 1024; }
        else if (pn < 12) { base = R; ldc = 1024; c0 = 2048; act = 2; }
        else if (pn < 16) { base = F; ldc = 1024; c0 = 3072; }
        else if (pn < 24) { base = GA; ldc = 2048; c0 = 4096; act = 3; }
        else if (pn < 32) { base = GB; ldc = 2048; c0 = 6144; act = 3; }
        else { base = LR; ldc = 256; c0 = 8192; }
        if (act == 1) v = v * 0.08838834764831845f;
        else if (act == 2) { v[0] *= sigmoidf_(v[0]); v[1] *= sigmoidf_(v[1]); v[2] *= sigmoidf_(v[2]); v[3] *= sigmoidf_(v[3]); }
        else if (act == 3) { v[0] = sigmoidf_(v[0]); v[1] = sigmoidf_(v[1]); v[2] = sigmoidf_(v[2]); v[3] = sigmoidf_(v[3]); }
        st_bf4(base + (size_t)row * ldc + (col - c0), v);
    }
};
struct EpiFn1 { static constexpr bool TILE = false; bf16_t* XT;
    __device__ __forceinline__ void put(const Unit& u, int row, int col, f32x4 v) const {
        st_bf4(XT + (size_t)u.bz * 256 * 4096 + (size_t)(row & 255) * 4096 + (row >> 8) * 2048 + col, v); } };
struct EpiFn2 { static constexpr bool TILE = false; bf16_t* Ff; float scale;
    __device__ __forceinline__ void put(const Unit& u, int row, int col, f32x4 v) const {
        st_bf4(Ff + (size_t)((u.bz >> 2) * SEQ + row) * FNW + (u.bz & 3) * 256 + col, v * scale); } };
struct EpiFn2S { static constexpr bool TILE = false; bf16_t* Ff; float scale;
    __device__ __forceinline__ void put(const Unit& u, int row, int col, f32x4 v) const {
        st_bf4(Ff + (size_t)((u.bz >> 2) * SEQ + row) * FNW + (u.bz & 3) * 256 + col, v * scale); } };
struct SchedPair { SchedGrid g;
    __device__ __forceinline__ bool next(int i, Unit& u) const { if (i >= 2) return false; const bool ok = g.decode(g.c, u); u.bz = i; return ok; } };
struct EpiYab { static constexpr bool TILE = false; const bf16_t* GA; const bf16_t* GB; float* YA; bf16_t* Y;
    __device__ __forceinline__ void put(const Unit& u, int row, int col, f32x4 v) const {
        const size_t o = (size_t)row * DM + col;
        if (u.bz == 0) st_bf4((bf16_t*)YA + o, ld_bf4(GA + o) * v);
        else st_bf4(Y + o, ld_bf4((const bf16_t*)YA + o) + ld_bf4(GB + o) * v); } };
struct EpiYa { static constexpr bool TILE = false; const bf16_t* GA; float* YA;
    __device__ __forceinline__ void put(const Unit& u, int row, int col, f32x4 v) const {
        const size_t o = (size_t)row * DM + col; *(f32x4*)(YA + o) = ld_bf4(GA + o) * v; } };
struct EpiYb { static constexpr bool TILE = false; const bf16_t* GB; const float* YA; bf16_t* Y;
    __device__ __forceinline__ void put(const Unit& u, int row, int col, f32x4 v) const {
        const size_t o = (size_t)row * DM + col; st_bf4(Y + o, *(const f32x4*)(YA + o) + ld_bf4(GB + o) * v); } };
struct EpiOut { static constexpr bool TILE = false; const float* x; const float* mod; float* X1;
    __device__ __forceinline__ void put(const Unit& u, int row, int col, f32x4 v) const {
        const size_t o = (size_t)row * DM + col; const f32x4 gt = *(const f32x4*)(mod + (row >> 11) * MODW + 2 * DM + col);
        *(f32x4*)(X1 + o) = *(const f32x4*)(x + o) + gt * v; } };
struct EpiUp { static constexpr bool TILE = false; bf16_t* U;
    __device__ __forceinline__ void put(const Unit& u, int row, int col, f32x4 v) const { st_bf4(U + (size_t)row * F2 + col, v); } };
struct EpiDown { static constexpr bool TILE = false; const float* mod; float* X;
    __device__ __forceinline__ void put(const Unit& u, int row, int col, f32x4 v) const {
        const size_t o = (size_t)row * DM + col; const f32x4 gt = *(const f32x4*)(mod + (row >> 11) * MODW + 5 * DM + col);
        *(f32x4*)(X + o) = *(const f32x4*)(X + o) + gt * v; } };

__device__ __forceinline__ float dpp_ror1(float v) { return __int_as_float(__builtin_amdgcn_update_dpp(0, __float_as_int(v), 0x121, 0xf, 0xf, false)); }
__device__ __forceinline__ float dpp_rol1(float v) { return __int_as_float(__builtin_amdgcn_update_dpp(0, __float_as_int(v), 0x12F, 0xf, 0xf, false)); }
struct EpiUpConv { static constexpr bool TILE = true;
    const float* cw; const float* cb; bf16_t* ACT;
    __device__ __forceinline__ void put(const Unit&, int, int, f32x4) const {}
    __device__ __forceinline__ void tile(const f32x4 (&acc)[2][2][4][2], const Unit& u, int wr, int wc, int fr, int fq) const {
#pragma unroll
        for (int n = 0; n < 2; ++n) {
            const int cv = 128 * u.pn + 32 * wc + 16 * n + 4 * fq, cg = FF + cv;
            const f32x4 wv0 = *(const f32x4*)(cw + cv), wv1 = *(const f32x4*)(cw + F2 + cv), wv2 = *(const f32x4*)(cw + 2 * F2 + cv), bv = *(const f32x4*)(cb + cv);
            const f32x4 wg0 = *(const f32x4*)(cw + cg), wg1 = *(const f32x4*)(cw + F2 + cg), wg2 = *(const f32x4*)(cw + 2 * F2 + cg), bg = *(const f32x4*)(cb + cg);
#pragma unroll
            for (int ai = 0; ai < 2; ++ai)
#pragma unroll
                for (int m = 0; m < 4; ++m) {
                    f32x4 r;
#pragma unroll
                    for (int i = 0; i < 4; ++i) {
                        const float xv = acc[ai][0][m][n][i], xg = acc[ai][1][m][n][i];
                        const float uv = m > 0 ? acc[ai][0][m > 0 ? m - 1 : 0][n][i] : 0.f, ug = m > 0 ? acc[ai][1][m > 0 ? m - 1 : 0][n][i] : 0.f;
                        const float dv = m < 3 ? acc[ai][0][m < 3 ? m + 1 : 3][n][i] : 0.f, dg = m < 3 ? acc[ai][1][m < 3 ? m + 1 : 3][n][i] : 0.f;
                        const float pv = dpp_ror1(fr == 15 ? uv : xv), pg = dpp_ror1(fr == 15 ? ug : xg);
                        const float nv = dpp_rol1(fr == 0 ? dv : xv), ng = dpp_rol1(fr == 0 ? dg : xg);
                        const float yv = wv0[i] * pv + wv1[i] * xv + wv2[i] * nv + bv[i];
                        const float yg = wg0[i] * pg + wg1[i] * xg + wg2[i] * ng + bg[i];
                        r[i] = yg * sigmoidf_(yg) * yv;
                    }
                    st_bf4(ACT + (size_t)(u.pm * BM + ai * HALF + wr * 64 + m * 16 + fr) * FF + cv, r);
                }
        }
    }
};

template <class Epi, class Sched>
__device__ __forceinline__ void gemm_naive(const GemmP g, const Sched& S, const Epi& E) {
    const int tid = threadIdx.x, rg = tid >> 3, cgi = tid & 7;
    Unit u;
    for (int i = 0; S.next(i, u); ++i) {
        const bf16_t* A = g.aptr(u) + (size_t)(rg * 4) * g.lda; const bf16_t* B = g.bptr(u);
        for (int j = 0; j < 8; ++j) {
            const int c = j * 32 + cgi * 4;
            const bf16_t* Bc = B + (size_t)c * g.ldb;
            float acc[4][4];
#pragma unroll
            for (int r = 0; r < 4; ++r)
#pragma unroll
                for (int cc = 0; cc < 4; ++cc) acc[r][cc] = 0.f;
            for (int k = 0; k < g.K; k += 8) {
                bf16x8 a[4], b[4];
#pragma unroll
                for (int r = 0; r < 4; ++r) { a[r] = *(const bf16x8*)(A + (size_t)r * g.lda + k); b[r] = *(const bf16x8*)(Bc + (size_t)r * g.ldb + k); }
#pragma unroll
                for (int e = 0; e < 8; ++e)
#pragma unroll
                    for (int r = 0; r < 4; ++r)
#pragma unroll
                        for (int cc = 0; cc < 4; ++cc) acc[r][cc] += bf2f((unsigned short)a[r][e]) * bf2f((unsigned short)b[cc][e]);
            }
#pragma unroll
            for (int r = 0; r < 4; ++r) E.put(u, u.pm * BM + rg * 4 + r, u.pn * BM + c, (f32x4){acc[r][0], acc[r][1], acc[r][2], acc[r][3]});
        }
    }
}

__device__ __forceinline__ int lds_byte(int r, int c) { const int st = (r >> 4) * 2 + (c >> 5), rr = r & 15, cc = c & 31, ob = rr * 64 + cc * 2; return st * 1024 + (ob ^ (((ob >> 9) & 1) << 5)); }
__device__ __forceinline__ void stage_rc(int b, int& R, int& C) { const int st = b / 1024, sb = b % 1024, swz = sb ^ (((sb >> 9) & 1) << 5); R = (st >> 1) * 16 + swz / 64; C = (st & 1) * 32 + (swz % 64) / 2; }

template <class Epi, class Sched, bool DEFER>
__device__ __forceinline__ void gemm_fast_core(LAS unsigned char* lds, const GemmP g, const Sched& S, const Epi& E, f32x4 (&acc)[2][2][4][2], Unit& cur) {
    int tid = threadIdx.x; asm volatile("" : "+v"(tid));
    const int wid = __builtin_amdgcn_readfirstlane(tid >> 6), lane = tid & 63, wr = wid >> 2, wc = wid & 3, fr = lane & 15, fq = lane >> 4;
    const int K = g.K, nt = K / BK;
    unsigned voffA[2], voffB[2];
#pragma unroll
    for (int i = 0; i < 2; ++i) { int R, C; stage_rc(tid * 16 + i * 8192, R, C); voffA[i] = (unsigned)(R * g.lda + C) * 2u; voffB[i] = (unsigned)(R * g.ldb + C) * 2u; }
    const size_t kstep = (size_t)(BK * 2);
    const size_t hstepA = (size_t)HALF * g.lda * 2, hstepB = (size_t)HALF * g.ldb * 2;
    const unsigned ldsw = (unsigned)wid * 1024u;
    const int aoff = lds_byte(wr * 64 + fr, fq * 8), boff = lds_byte(wc * 32 + fr, fq * 8);
#define PG8_SA(b, h) (((b) * 2 + (h)) * HTB)
#define PG8_SB(b, h) ((4 + (b) * 2 + (h)) * HTB)
#define PG8_STAGE(bufoff, gbase, voff) do { _Pragma("unroll") for (int _i = 0; _i < 2; ++_i) \
        __builtin_amdgcn_global_load_lds((const unsigned*)((const char*)(gbase) + (voff)[_i]), (LAS unsigned*)(lds + (bufoff) + ldsw + _i * 8192), 16, 0, 0); } while (0)
#define PG8_LDA(dst, b, h) do { _Pragma("unroll") for (int m = 0; m < 4; ++m) _Pragma("unroll") for (int k = 0; k < 2; ++k) dst[m][k] = *(const LAS bf16x8*)(lds + PG8_SA(b, h) + aoff + m * 2048 + k * 1024); } while (0)
#define PG8_LDB(dst, b, h) do { _Pragma("unroll") for (int n = 0; n < 2; ++n) _Pragma("unroll") for (int k = 0; k < 2; ++k) dst[n][k] = *(const LAS bf16x8*)(lds + PG8_SB(b, h) + boff + n * 2048 + k * 1024); } while (0)
#define PG8_MMA(ai, bj, At, Bt) do { __builtin_amdgcn_s_setprio(1); _Pragma("unroll") for (int m = 0; m < 4; ++m) _Pragma("unroll") for (int n = 0; n < 2; ++n) _Pragma("unroll") for (int k = 0; k < 2; ++k) \
        acc[ai][bj][m][n] = __builtin_amdgcn_mfma_f32_16x16x32_bf16(Bt[n][k], At[m][k], acc[ai][bj][m][n], 0, 0, 0); __builtin_amdgcn_s_setprio(0); } while (0)
#define PG8_WAIT_V(n) asm volatile("s_waitcnt vmcnt(" #n ")" ::: "memory")
#define PG8_WAIT_L(n) asm volatile("s_waitcnt lgkmcnt(" #n ")" ::: "memory")
#define PG8_BAR __builtin_amdgcn_s_barrier()
#define PG8_SCHED __builtin_amdgcn_sched_barrier(0)
    Unit nxt; int ui = 0;
    if (!S.next(0, cur)) return;
#pragma unroll
    for (int a = 0; a < 2; ++a)
#pragma unroll
        for (int b = 0; b < 2; ++b)
#pragma unroll
            for (int m = 0; m < 4; ++m)
#pragma unroll
                for (int n = 0; n < 2; ++n) acc[a][b][m][n] = (f32x4){0.f, 0.f, 0.f, 0.f};
    bf16x8 At[4][2], B0[2][2], B1[2][2];
    const char* cA = (const char*)g.aptr(cur); const char* cB = (const char*)g.bptr(cur);
    PG8_STAGE(PG8_SB(0, 0), cB, voffB); PG8_STAGE(PG8_SB(0, 1), cB + hstepB, voffB); PG8_STAGE(PG8_SA(0, 0), cA, voffA); PG8_STAGE(PG8_SA(0, 1), cA + hstepA, voffA);
    if (wr == 1) PG8_BAR;
    PG8_WAIT_V(2); PG8_BAR;
    PG8_STAGE(PG8_SB(1, 0), cB + kstep, voffB); PG8_STAGE(PG8_SA(1, 0), cA + kstep, voffA); PG8_STAGE(PG8_SB(1, 1), cB + hstepB + kstep, voffB);
    PG8_WAIT_V(6); PG8_BAR;
    for (;;) {
        const bool has_next = S.next(ui + 1, nxt);
        const char* nA = has_next ? (const char*)g.aptr(nxt) : cA; const char* nB = has_next ? (const char*)g.bptr(nxt) : cB;
        for (int t = 0; t < nt; t += 2) {
            const bool last = (t == nt - 2);
            const char* a1 = cA + (size_t)(t + 1) * kstep;
            const char* a2 = last ? nA : cA + (size_t)(t + 2) * kstep; const char* b2 = last ? nB : cB + (size_t)(t + 2) * kstep;
            const char* a3 = a2 + kstep; const char* b3 = b2 + kstep;
            PG8_LDB(B0, 0, 0); PG8_LDB(B1, 0, 1); PG8_SCHED; PG8_LDA(At, 0, 0); PG8_STAGE(PG8_SA(1, 1), a1 + hstepA, voffA);
            PG8_WAIT_V(8); PG8_WAIT_L(0); PG8_BAR; PG8_MMA(0, 0, At, B0); PG8_MMA(0, 1, At, B1); PG8_BAR; PG8_SCHED;
            PG8_LDA(At, 0, 1); PG8_STAGE(PG8_SB(0, 0), b2, voffB); PG8_STAGE(PG8_SB(0, 1), b2 + hstepB, voffB); PG8_STAGE(PG8_SA(0, 0), a2, voffA);
            PG8_WAIT_V(8); PG8_WAIT_L(0); PG8_BAR; PG8_MMA(1, 0, At, B0); PG8_MMA(1, 1, At, B1); PG8_BAR; PG8_SCHED;
            PG8_LDB(B0, 1, 0); PG8_LDB(B1, 1, 1); PG8_SCHED; PG8_LDA(At, 1, 0); PG8_STAGE(PG8_SA(0, 1), a2 + hstepA, voffA);
            PG8_WAIT_V(8); PG8_WAIT_L(0); PG8_BAR; PG8_MMA(0, 0, At, B0); PG8_MMA(0, 1, At, B1); PG8_BAR; PG8_SCHED;
            PG8_LDA(At, 1, 1); PG8_STAGE(PG8_SB(1, 0), b3, voffB); PG8_STAGE(PG8_SB(1, 1), b3 + hstepB, voffB); PG8_STAGE(PG8_SA(1, 0), a3, voffA);
            PG8_WAIT_V(8); PG8_WAIT_L(0); PG8_BAR; PG8_MMA(1, 0, At, B0); PG8_MMA(1, 1, At, B1); PG8_BAR; PG8_SCHED;
        }
        if (wr == 0) PG8_BAR;
        if constexpr (DEFER) {   }
        else if constexpr (Epi::TILE) E.tile(acc, cur, wr, wc, fr, fq);
        else {
            const int row0 = cur.pm * BM + wr * 64 + fr, col0 = cur.pn * BM + wc * 32 + 4 * fq;
#pragma unroll
            for (int ai = 0; ai < 2; ++ai)
#pragma unroll
                for (int m = 0; m < 4; ++m)
#pragma unroll
                    for (int bj = 0; bj < 2; ++bj)
#pragma unroll
                        for (int n = 0; n < 2; ++n) E.put(cur, row0 + ai * HALF + m * 16, col0 + bj * HALF + n * 16, acc[ai][bj][m][n]);
        }
        if (!has_next) break;
#pragma unroll
        for (int a = 0; a < 2; ++a)
#pragma unroll
            for (int b = 0; b < 2; ++b)
#pragma unroll
                for (int m = 0; m < 4; ++m)
#pragma unroll
                    for (int n = 0; n < 2; ++n) acc[a][b][m][n] = (f32x4){0.f, 0.f, 0.f, 0.f};
        cur = nxt; cA = nA; cB = nB; ++ui;
        if (wr == 1) PG8_BAR;
    }
    PG8_WAIT_V(0);
    PG8_BAR;
#undef PG8_SA
#undef PG8_SB
#undef PG8_STAGE
#undef PG8_LDA
#undef PG8_LDB
#undef PG8_MMA
#undef PG8_WAIT_V
#undef PG8_WAIT_L
#undef PG8_BAR
#undef PG8_SCHED
}
template <class Epi, class Sched>
__device__ __forceinline__ void gemm_fast(LAS unsigned char* lds, const GemmP g, const Sched& S, const Epi& E) {
    f32x4 acc[2][2][4][2]; Unit cur;
    gemm_fast_core<Epi, Sched, false>(lds, g, S, E, acc, cur);
}
struct EpiNone { static constexpr bool TILE = false; __device__ __forceinline__ void put(const Unit&, int, int, f32x4) const {} };
__device__ __forceinline__ void tile_rowsq_publish(const f32x4 (&v)[2][2][4][2], const Unit& u, LAS unsigned char* lds, float* slots) {
    int tid = threadIdx.x; asm volatile("" : "+v"(tid));
    const int wid = __builtin_amdgcn_readfirstlane(tid >> 6), lane = tid & 63, wr = wid >> 2, wc = wid & 3, fr = lane & 15, fq = lane >> 4;
    LAS float* red = (LAS float*)lds;
#pragma unroll
    for (int ai = 0; ai < 2; ++ai)
#pragma unroll
        for (int m = 0; m < 4; ++m) { float sq = 0.f;
#pragma unroll
            for (int bj = 0; bj < 2; ++bj)
#pragma unroll
                for (int n = 0; n < 2; ++n) { const f32x4 x = v[ai][bj][m][n]; sq += (x[0] * x[0] + x[1] * x[1]) + (x[2] * x[2] + x[3] * x[3]); }
            sq += __shfl_xor(sq, 16); sq += __shfl_xor(sq, 32);
            if (fq == 0) red[(ai * HALF + wr * 64 + m * 16 + fr) * 4 + wc] = sq; }
    __syncthreads();
    if (tid < 256) { const f32x4 r = *(const LAS f32x4*)(red + tid * 4); slots[(size_t)(u.pm * BM + tid) * 8 + u.pn] = (r[0] + r[1]) + (r[2] + r[3]); }
}
__device__ __forceinline__ float row_rstd(const float* slots, int row) {
    const unsigned long long* sp = (const unsigned long long*)(slots + (size_t)row * 8); float t = 0.f;
#pragma unroll
    for (int q = 0; q < 4; ++q) { const unsigned long long w = __hip_atomic_load(sp + q, __ATOMIC_RELAXED, __HIP_MEMORY_SCOPE_AGENT); t += __uint_as_float((unsigned)w) + __uint_as_float((unsigned)(w >> 32)); }
    return rsqrtf(t * (1.0f / DM) + EPS);
}

template <class Epi, class Sched>
__device__ __forceinline__ void gemm_run(LAS unsigned char* lds, const GemmP g, const Sched& S, const Epi& E) {
#if GEMM_FAST
    gemm_fast(lds, g, S, E);
#else
    gemm_naive(g, S, E);
#endif
}


__device__ __forceinline__ f32x4 mma16(bf16x8 afrag, bf16x8 bfrag, f32x4 acc) { return __builtin_amdgcn_mfma_f32_16x16x32_bf16(bfrag, afrag, acc, 0, 0, 0); }
constexpr int GLA_NCH = 36;
template <int CTRL> __device__ __forceinline__ float dppz(float v) { return __int_as_float(__builtin_amdgcn_update_dpp(0, __float_as_int(v), CTRL, 0xf, 0xf, true)); }
#define LBAR() do { asm volatile("s_waitcnt lgkmcnt(0)" ::: "memory"); __builtin_amdgcn_s_barrier(); asm volatile("" ::: "memory"); } while (0)
__device__ __forceinline__ void gla_prep(LAS unsigned char* lds, int ufirst, int ucount, const bf16_t* Qb, const bf16_t* Kb, const bf16_t* Vb, const bf16_t* LR,
                                         const float* wgf, const float* bgf, const float* wgb, const float* bgb,
                                         bf16_t* KS, bf16_t* QD, bf16_t* VT, float* DEC, bf16_t* Of, bf16_t* Ob) {
    int tid = threadIdx.x; asm volatile("" : "+v"(tid));
    const int lane = tid & 63, wave = __builtin_amdgcn_readfirstlane(tid >> 6), fr = lane & 15, fq = lane >> 4;
    LAS bf16_t* qd = (LAS bf16_t*)lds; LAS bf16_t* kd = qd + 64 * 136; LAS bf16_t* sc = kd + 64 * 136; LAS bf16_t* vT = sc + 64 * 72;
    LAS bf16_t* ksT = vT + 256 * 72;
#pragma unroll 1
    for (int ui = 0; ui < ucount; ++ui) {
        const int unit = ufirst + ui;
        const int bh = unit / (2 * GLA_NCH), rem = unit % (2 * GLA_NCH), dir = rem / GLA_NCH, cidx = rem % GLA_NCH, b = bh >> 2, h = bh & 3;
        const bool lat = cidx >= 4;
        const int row0 = lat ? b * SEQ + (cidx - 4) * 64 : M + b * CTX + cidx * 64;
        const int kidx = (bh * 2 + dir) * GLA_NCH + cidx, qidx = (bh * 2 + dir) * 32 + (cidx - 4);
        const float* wsrc = dir ? wgb : wgf; const float* bsrc = dir ? bgb : bgf;
        LBAR();
        if (lat || dir == 0) {
#pragma unroll
            for (int j = 0; j < 4; ++j) { const int idx = tid + 512 * j, sp = idx & 63, c8 = (idx >> 6) * 8; const bf16x8 v = *(const bf16x8*)(Vb + (size_t)(row0 + sp) * VW + h * DV + c8);
#pragma unroll
                for (int e = 0; e < 8; ++e) vT[(c8 + e) * 72 + sp] = (bf16_t)v[e]; }
        }
        bf16x8 afr[4], bfr;
#pragma unroll
        for (int pt = 0; pt < 4; ++pt) afr[pt] = *(const bf16x8*)(LR + (size_t)(row0 + 16 * pt + fr) * 256 + dir * 16 + (fq & 1) * 8);
        { const float* wp = wsrc + (size_t)((fq & 1) * 8) * QKW + h * DK + 16 * wave + fr;
#pragma unroll
          for (int e = 0; e < 8; ++e) { const float wv = wp[e * QKW]; const unsigned hi = f2bfhw(wv); const float res = wv - bf2f((unsigned short)hi); bfr[e] = (short)(fq < 2 ? hi : f2bfhw(res)); } }
        const f32x4 bias4 = *(const f32x4*)(bsrc + h * DK + 16 * wave + 4 * fq);
        f32x4 k4[4], q4[4];
#pragma unroll
        for (int pt = 0; pt < 4; ++pt) { const size_t o = (size_t)(row0 + 16 * pt + fr) * QKW + h * DK + 16 * wave + 4 * fq; k4[pt] = ld_bf4(Kb + o); q4[pt] = lat ? ld_bf4(Qb + o) : (f32x4){0.f, 0.f, 0.f, 0.f}; }
        f32x4 la[4];
#pragma unroll
        for (int pt = 0; pt < 4; ++pt) { const f32x4 z = mma16(afr[pt], bfr, bias4);
#pragma unroll
            for (int i = 0; i < 4; ++i) { float x = (fminf(z[i], 0.f) - __logf(1.0f + __expf(-fabsf(z[i])))) * (1.0f / 16.0f);
                if (!dir) { x += dppz<0x111>(x); x += dppz<0x112>(x); x += dppz<0x114>(x); x += dppz<0x118>(x); }
                else      { x += dppz<0x101>(x); x += dppz<0x102>(x); x += dppz<0x104>(x); x += dppz<0x108>(x); }
                la[pt][i] = x; } }
        f32x4 carry = (f32x4){0.f, 0.f, 0.f, 0.f};
        if (!dir) {
#pragma unroll
            for (int pt = 0; pt < 4; ++pt) { f32x4 t;
#pragma unroll
                for (int i = 0; i < 4; ++i) t[i] = __shfl(la[pt][i], (lane & 48) | 15);
                la[pt] += carry; carry += t; }
        } else {
#pragma unroll
            for (int pt = 3; pt >= 0; --pt) { f32x4 t;
#pragma unroll
                for (int i = 0; i < 4; ++i) t[i] = __shfl(la[pt][i], lane & 48);
                la[pt] += carry; carry += t; }
        }
        const f32x4 blast = carry;
#pragma unroll
        for (int pt = 0; pt < 4; ++pt) { const int p = 16 * pt + fr;
            f32x4 ks, qn, kn;
#pragma unroll
            for (int i = 0; i < 4; ++i) { const float bv = la[pt][i]; ks[i] = k4[pt][i] * __expf(blast[i] - bv); qn[i] = q4[pt][i] * __expf(bv); kn[i] = k4[pt][i] * __expf(-bv); }
            const unsigned k01 = pk2hw(ks[0], ks[1]), k23 = pk2hw(ks[2], ks[3]);
            LAS bf16_t* kt = ksT + (16 * wave + 4 * fq) * 72 + p;
            kt[0] = (bf16_t)(k01 & 0xffffu); kt[72] = (bf16_t)(k01 >> 16); kt[144] = (bf16_t)(k23 & 0xffffu); kt[216] = (bf16_t)(k23 >> 16);
            if (lat) { u32x2 w; w.x = pk2hw(qn[0], qn[1]); w.y = pk2hw(qn[2], qn[3]); *(LAS u32x2*)(qd + p * 136 + 16 * wave + 4 * fq) = w;
                       w.x = pk2hw(kn[0], kn[1]); w.y = pk2hw(kn[2], kn[3]); *(LAS u32x2*)(kd + p * 136 + 16 * wave + 4 * fq) = w; } }
        if (fr == 0) { f32x4 dv; dv[0] = __expf(blast[0]); dv[1] = __expf(blast[1]); dv[2] = __expf(blast[2]); dv[3] = __expf(blast[3]); *(f32x4*)(DEC + kidx * 128 + 16 * wave + 4 * fq) = dv; }
        LBAR();
#pragma unroll
        for (int j = 0; j < 2; ++j) { const int idx = tid + 512 * j, dd = idx >> 3, part = idx & 7;
            *(u32x4*)(KS + (size_t)kidx * 8192 + ((((dd >> 4) * 2 + (part >> 2)) * 64 + (part & 3) * 16 + (dd & 15)) << 3)) = *(const LAS u32x4*)(ksT + dd * 72 + part * 8); }
        if (dir == 0) {
#pragma unroll
            for (int j = 0; j < 4; ++j) { const int idx = tid + 512 * j, v = idx >> 3, part = idx & 7;
                *(u32x4*)(VT + (size_t)(bh * GLA_NCH + cidx) * 16384 + ((((v >> 4) * 2 + (part >> 2)) * 64 + (part & 3) * 16 + (v & 15)) << 3)) = *(const LAS u32x4*)(vT + v * 72 + part * 8); }
        }
        if (lat) {
#pragma unroll
            for (int j = 0; j < 2; ++j) { const int idx = tid + 512 * j, pr = idx >> 4, part = idx & 15;
                *(u32x4*)(QD + (size_t)qidx * 8192 + ((((pr >> 4) * 4 + (part >> 2)) * 64 + (part & 3) * 16 + (pr & 15)) << 3)) = *(const LAS u32x4*)(qd + pr * 136 + part * 8); }
            { const int ct = wave >> 1; f32x4 acc[2] = {(f32x4){0.f, 0.f, 0.f, 0.f}, (f32x4){0.f, 0.f, 0.f, 0.f}};
#pragma unroll
                for (int k0 = 0; k0 < 4; ++k0) { const bf16x8 af = *(const LAS bf16x8*)(qd + (16 * ct + fr) * 136 + k0 * 32 + fq * 8);
#pragma unroll
                    for (int j = 0; j < 2; ++j) { const int st = (wave & 1) * 2 + j; const bf16x8 bf = *(const LAS bf16x8*)(kd + (16 * st + fr) * 136 + k0 * 32 + fq * 8); acc[j] = mma16(af, bf, acc[j]); } }
#pragma unroll
                for (int j = 0; j < 2; ++j) { const int st = (wave & 1) * 2 + j, c = 16 * ct + fr; f32x4 v = acc[j];
#pragma unroll
                    for (int i = 0; i < 4; ++i) { const int sp = 16 * st + 4 * fq + i; const bool keep = dir ? (sp >= c) : (sp <= c); v[i] = keep ? v[i] : 0.f; }
                    u32x2 w; w.x = pk2hw(v[0], v[1]); w.y = pk2hw(v[2], v[3]); *(LAS u32x2*)(sc + c * 72 + 16 * st + 4 * fq) = w; }
            }
            LBAR();
            { f32x4 acc[4][2];
#pragma unroll
                for (int ct = 0; ct < 4; ++ct) { acc[ct][0] = (f32x4){0.f, 0.f, 0.f, 0.f}; acc[ct][1] = (f32x4){0.f, 0.f, 0.f, 0.f}; }
#pragma unroll
                for (int k0 = 0; k0 < 2; ++k0) { bf16x8 bf[2];
#pragma unroll
                    for (int j = 0; j < 2; ++j) bf[j] = *(const LAS bf16x8*)(vT + (16 * (2 * wave + j) + fr) * 72 + k0 * 32 + fq * 8);
#pragma unroll
                    for (int ct = 0; ct < 4; ++ct) { const bf16x8 af = *(const LAS bf16x8*)(sc + (16 * ct + fr) * 72 + k0 * 32 + fq * 8);
                        acc[ct][0] = mma16(af, bf[0], acc[ct][0]); acc[ct][1] = mma16(af, bf[1], acc[ct][1]); } }
                bf16_t* O = dir ? Ob : Of;
#pragma unroll
                for (int ct = 0; ct < 4; ++ct)
#pragma unroll
                    for (int j = 0; j < 2; ++j) st_bf4(O + (((((((size_t)(b * 32 + cidx - 4) * 4 + h) * 8 + wave) * 4 + ct) * 2 + j) * 64 + lane) << 2), acc[ct][j]);
            }
        }
    }
    LBAR();
}
__device__ __forceinline__ void gla_scan(LAS unsigned char* lds, int bx, int G, const bf16_t* KS, const bf16_t* QD, const bf16_t* VT, const float* DEC, bf16_t* Of, bf16_t* Ob) {
    int tid = threadIdx.x; asm volatile("" : "+v"(tid));
    const int lane = tid & 63, wave = __builtin_amdgcn_readfirstlane(tid >> 6), fr = lane & 15, fq = lane >> 4;
    LAS bf16_t* ST = (LAS bf16_t*)lds;
    for (int unit = bx; unit < 256; unit += G) {
        const int vs = unit & 7, dir = (unit >> 3) & 1, bh = unit >> 4, b = bh >> 2, h = bh & 3;
        bf16_t* O = dir ? Ob : Of;
        f32x4 S0 = (f32x4){0.f, 0.f, 0.f, 0.f}, S1 = S0;
        const bf16x8 z8 = (bf16x8){0, 0, 0, 0, 0, 0, 0, 0};
#define GLB_DECL(P) bf16x8 P##ks0 = z8, P##ks1 = z8, P##v00 = z8, P##v01 = z8, P##v10 = z8, P##v11 = z8, P##q0 = z8, P##q1 = z8, P##q2 = z8, P##q3 = z8; float P##dec = 0.f; u32x2 P##oin = (u32x2){0u, 0u}; int P##row0 = 0;
        GLB_DECL(a_) GLB_DECL(b_) GLB_DECL(c_) GLB_DECL(d_)
#define GLB_LOAD(step_, P) do { const int st_ = (step_) < GLA_NCH ? (step_) : GLA_NCH - 1;     \
        const int cidx_ = st_ < 4 ? (dir ? 3 - st_ : st_) : (dir ? 39 - st_ : st_);                  \
        const int kidx_ = (bh * 2 + dir) * GLA_NCH + cidx_; const bf16_t* ksp_ = KS + (size_t)kidx_ * 8192 + ((wave * 2 * 64 + lane) << 3); \
        P##ks0 = *(const bf16x8*)ksp_; P##ks1 = *(const bf16x8*)(ksp_ + 512); \
        const bf16_t* vtp_ = VT + (size_t)(bh * GLA_NCH + cidx_) * 16384 + ((vs * 4 * 64 + lane) << 3); \
        P##v00 = *(const bf16x8*)vtp_; P##v01 = *(const bf16x8*)(vtp_ + 512); P##v10 = *(const bf16x8*)(vtp_ + 1024); P##v11 = *(const bf16x8*)(vtp_ + 1536); \
        P##dec = DEC[kidx_ * 128 + 16 * wave + fr]; \
        { const int lc_ = cidx_ >= 4 ? cidx_ - 4 : 0; const bf16_t* qp_ = QD + (size_t)((bh * 2 + dir) * 32 + lc_) * 8192 + (((wave >> 1) * 4 * 64 + lane) << 3); \
            P##q0 = *(const bf16x8*)qp_; P##q1 = *(const bf16x8*)(qp_ + 512); P##q2 = *(const bf16x8*)(qp_ + 1024); P##q3 = *(const bf16x8*)(qp_ + 1536); \
            P##row0 = lc_; \
            P##oin = *(const u32x2*)(O + (((((((size_t)(b * 32 + P##row0) * 4 + h) * 8 + vs) * 4 + (wave >> 1)) * 2 + (wave & 1)) * 64 + lane) << 2)); } } while (0)
#define GLB_STEP(step_, P, LAT_) do { const int sp_ = (step_); \
        if (LAT_) { const LAS bf16_t* stb = ST + ((sp_ - 1) & 1) * (32 * 136) + (16 * (wave & 1) + fr) * 136 + fq * 8; \
            f32x4 acc = (f32x4){0.f, 0.f, 0.f, 0.f}; \
            acc = mma16(P##q0, *(const LAS bf16x8*)(stb), acc); acc = mma16(P##q1, *(const LAS bf16x8*)(stb + 32), acc); \
            acc = mma16(P##q2, *(const LAS bf16x8*)(stb + 64), acc); acc = mma16(P##q3, *(const LAS bf16x8*)(stb + 96), acc); \
            const f32x4 oi_ = (f32x4){__uint_as_float(P##oin.x << 16), __uint_as_float(P##oin.x & 0xffff0000u), __uint_as_float(P##oin.y << 16), __uint_as_float(P##oin.y & 0xffff0000u)}; \
            st_bf4(O + (((((((size_t)(b * 32 + P##row0) * 4 + h) * 8 + vs) * 4 + (wave >> 1)) * 2 + (wave & 1)) * 64 + lane) << 2), oi_ + acc); } \
        S0 = S0 * P##dec; S1 = S1 * P##dec; \
        S0 = mma16(P##ks0, P##v00, S0); S0 = mma16(P##ks1, P##v01, S0); S1 = mma16(P##ks0, P##v10, S1); S1 = mma16(P##ks1, P##v11, S1); \
        { LAS bf16_t* stw = ST + (sp_ & 1) * (32 * 136) + 16 * wave + fr; \
          _Pragma("unroll") for (int i = 0; i < 4; ++i) { stw[(4 * fq + i) * 136] = (bf16_t)f2bfhw(S0[i]); stw[(16 + 4 * fq + i) * 136] = (bf16_t)f2bfhw(S1[i]); } } \
        asm volatile("s_waitcnt lgkmcnt(0)" ::: "memory"); __builtin_amdgcn_s_barrier(); asm volatile("" ::: "memory"); } while (0)
        __syncthreads();
        GLB_LOAD(0, a_); GLB_LOAD(1, b_); GLB_LOAD(2, c_);
        GLB_LOAD(3, d_); GLB_STEP(0, a_, false);
        GLB_LOAD(4, a_); GLB_STEP(1, b_, false);
        GLB_LOAD(5, b_); GLB_STEP(2, c_, false);
        GLB_LOAD(6, c_); GLB_STEP(3, d_, false);
#pragma unroll 1
        for (int step = 4; step < GLA_NCH; step += 4) {
            GLB_LOAD(step + 3, d_); GLB_STEP(step, a_, true);
            GLB_LOAD(step + 4, a_); GLB_STEP(step + 1, b_, true);
            GLB_LOAD(step + 5, b_); GLB_STEP(step + 2, c_, true);
            GLB_LOAD(step + 6, c_); GLB_STEP(step + 3, d_, true);
        }
#undef GLB_STEP
#undef GLB_DECL
#undef GLB_LOAD
    }
    __syncthreads();
}

#define XB_TMO      128
#define XB_XCNT(j)  (256  + 64 * (j))
#define XB_XSUB(j)  (1280 + 64 * (j))
#define XB_XGEN(j)  (2304 + 64 * (j))
#define XB_TOP      3328
#define XB_TOPGEN   3392
#define XCD_BAR_WORDS 3456
#define XB_SPIN_CAP (1u << 18)

__device__ __forceinline__ unsigned xb_ld(unsigned* p)              { return __hip_atomic_load(p, __ATOMIC_RELAXED, __HIP_MEMORY_SCOPE_AGENT); }
__device__ __forceinline__ unsigned xb_add(unsigned* p, unsigned v) { return __hip_atomic_fetch_add(p, v, __ATOMIC_RELAXED, __HIP_MEMORY_SCOPE_AGENT); }
__device__ __forceinline__ unsigned xb_xcc_id() { return (unsigned)__builtin_amdgcn_s_getreg((3 << 11) | 20) & 0xFu; }
#define XB_SPIN(cond, bar) do { unsigned _sp = 0; while (cond) { __builtin_amdgcn_s_sleep(1); \
    if ((++_sp & 255u) == 0u) { if (xb_ld(&(bar)[XB_TMO])) break; if (_sp > XB_SPIN_CAP) { atomicAdd(&(bar)[XB_TMO], 1u); break; } } } } while (0)

struct XcdBarrier {
    unsigned* bar; unsigned x;
    volatile LAS unsigned* st;
};

__device__ __forceinline__ XcdBarrier xcd_barrier_post(unsigned* bar, volatile LAS unsigned* st) {
    XcdBarrier b; b.bar = bar; b.x = xb_xcc_id(); b.st = st;
    if (threadIdx.x == 0) (void)xb_add(&bar[XB_XCNT(b.x)], 1u);
    return b;
}
__device__ __forceinline__ void xcd_barrier_complete(unsigned* bar, unsigned x, unsigned& nloc, unsigned& nx) {
    const unsigned G = gridDim.x * gridDim.y * gridDim.z;
    unsigned sum, cnt, mine, sp = 0u;
    for (;;) {
        sum = 0u; cnt = 0u; mine = 0u;
#pragma unroll
        for (unsigned j = 0; j < 16; ++j) { const unsigned c = xb_ld(&bar[XB_XCNT(j)]); sum += c; cnt += (c > 0u) ? 1u : 0u; mine = (j == x) ? c : mine; }
        if (sum == G) break;
        __builtin_amdgcn_s_sleep(1);
        if ((++sp & 255u) == 0u) { if (xb_ld(&bar[XB_TMO])) break; if (sp > XB_SPIN_CAP) { atomicAdd(&bar[XB_TMO], 1u); break; } }
    }
    nloc = mine > 0u ? mine : 1u; nx = cnt > 0u ? cnt : 1u;
}

__device__ __forceinline__ void xcd_barrier(const XcdBarrier& b) {
    asm volatile("s_waitcnt vmcnt(0)" ::: "memory");
    __syncthreads();
    if (threadIdx.x == 0) {
        unsigned* bar = b.bar;
        __builtin_amdgcn_s_waitcnt(0);
        unsigned nloc = b.st[0], nx = b.st[1];
        if (nloc == 0u) { xcd_barrier_complete(bar, b.x, nloc, nx); b.st[0] = nloc; b.st[1] = nx; }
        const unsigned old = xb_add(&bar[XB_XSUB(b.x)], 1u);
        const unsigned gen = old / nloc;
        if (old + 1u == (gen + 1u) * nloc) {
            __builtin_amdgcn_fence(__ATOMIC_RELEASE, "agent");
            asm volatile("s_waitcnt vmcnt(0)" ::: "memory");
            const unsigned og = xb_add(&bar[XB_TOP], 1u);
            const unsigned tg = og / nx;
            if (og + 1u == (tg + 1u) * nx) xb_add(&bar[XB_TOPGEN], 1u);
            else XB_SPIN(xb_ld(&bar[XB_TOPGEN]) == tg, bar);
            __builtin_amdgcn_fence(__ATOMIC_ACQUIRE, "agent");
            xb_add(&bar[XB_XGEN(b.x)], 1u);
            asm volatile("s_waitcnt vmcnt(0)" ::: "memory");
        } else {
            XB_SPIN(xb_ld(&bar[XB_XGEN(b.x)]) == gen, bar);
            __builtin_amdgcn_fence(__ATOMIC_ACQUIRE, "agent");
            asm volatile("s_waitcnt vmcnt(0)" ::: "memory");
        }
    }
    __syncthreads();
}
__device__ __forceinline__ void xcd_barrier_light(const XcdBarrier& b) {
    asm volatile("s_waitcnt vmcnt(0)" ::: "memory");
    __syncthreads();
    if (threadIdx.x == 0) {
        unsigned* bar = b.bar;
        __builtin_amdgcn_s_waitcnt(0);
        unsigned nloc = b.st[0], nx = b.st[1];
        if (nloc == 0u) { xcd_barrier_complete(bar, b.x, nloc, nx); b.st[0] = nloc; b.st[1] = nx; }
        const unsigned old = xb_add(&bar[XB_XSUB(b.x)], 1u);
        const unsigned gen = old / nloc;
        if (old + 1u == (gen + 1u) * nloc) {
            asm volatile("s_waitcnt vmcnt(0)" ::: "memory");
            const unsigned og = xb_add(&bar[XB_TOP], 1u);
            const unsigned tg = og / nx;
            if (og + 1u == (tg + 1u) * nx) xb_add(&bar[XB_TOPGEN], 1u);
            else XB_SPIN(xb_ld(&bar[XB_TOPGEN]) == tg, bar);
            xb_add(&bar[XB_XGEN(b.x)], 1u);
            asm volatile("s_waitcnt vmcnt(0)" ::: "memory");
        } else {
            XB_SPIN(xb_ld(&bar[XB_XGEN(b.x)]) == gen, bar);
            asm volatile("s_waitcnt vmcnt(0)" ::: "memory");
        }
    }
    __syncthreads();
}

__device__ __forceinline__ void transpose_item(const float* W, int K, int N, bf16_t* WT, int drow0, LAS float* scr, int k0, int n0, int lane) {
#pragma unroll 8
    for (int i = 0; i < 32; ++i) { const int kk = 2 * i + (lane >> 5); scr[kk * 33 + (lane & 31)] = W[(size_t)(k0 + kk) * N + n0 + (lane & 31)]; }
    asm volatile("s_waitcnt lgkmcnt(0)" ::: "memory");
    const int c = lane & 7;
#pragma unroll
    for (int j = 0; j < 4; ++j) { const int n = (lane >> 3) + 8 * j; const LAS float* s = scr + (8 * c) * 33 + n;
        u32x4 o; o.x = pk2(s[0 * 33], s[1 * 33]); o.y = pk2(s[2 * 33], s[3 * 33]); o.z = pk2(s[4 * 33], s[5 * 33]); o.w = pk2(s[6 * 33], s[7 * 33]);
        *(u32x4*)(WT + (size_t)(drow0 + n) * K + k0 + 8 * c) = o; }
    asm volatile("s_waitcnt lgkmcnt(0)" ::: "memory");
}

template <int MODOFF, int STORE  , bool BASE_BF16>
__device__ __forceinline__ void epi_rows_part1(LAS unsigned char* lds, const f32x4 (&acc)[2][2][4][2], const Unit& u, const float* base, const float* mod, float* outp, float* slots, f32x4 (&xr)[2][16]) {
    int tid = threadIdx.x; asm volatile("" : "+v"(tid));
    const int wid = __builtin_amdgcn_readfirstlane(tid >> 6), lane = tid & 63, wr = wid >> 2, wc = wid & 3, fr = lane & 15, fq = lane >> 4;
    LAS float* T = (LAS float*)lds;
    const int colg = u.pn * BM + 4 * lane;
    const f32x4 gt = *(const f32x4*)(mod + ((u.pm * BM) >> 11) * MODW + MODOFF * DM + colg);
#pragma unroll
    for (int ai = 0; ai < 2; ++ai) {
        if (ai) LBAR();
#pragma unroll
        for (int m = 0; m < 4; ++m)
#pragma unroll
            for (int bj = 0; bj < 2; ++bj)
#pragma unroll
                for (int n = 0; n < 2; ++n) { const int rl = wr * 64 + m * 16 + fr, c4 = (bj * HALF + wc * 32 + n * 16 + 4 * fq) >> 2;
                    *(LAS f32x4*)(T + rl * 256 + ((c4 ^ (rl & 15)) << 2)) = acc[ai][bj][m][n]; }
        LBAR();
#pragma unroll
        for (int j = 0; j < 16; ++j) { const int rl = wid * 16 + j, row = u.pm * BM + ai * HALF + rl; const size_t o = (size_t)row * DM + colg;
            const f32x4 v = *(const LAS f32x4*)(T + rl * 256 + ((lane ^ j) << 2));
            const f32x4 bs = BASE_BF16 ? ld_bf4((const bf16_t*)base + o) : *(const f32x4*)(base + o);
            const f32x4 x1 = bs + gt * v; xr[ai][j] = x1; if (STORE == 2) st_bf4((bf16_t*)outp + o, x1);
            const float sq = wave_sum((x1[0] * x1[0] + x1[1] * x1[1]) + (x1[2] * x1[2] + x1[3] * x1[3]));
            if (lane == 0) __hip_atomic_store((unsigned*)slots + (size_t)row * 8 + u.pn, __float_as_uint(sq), __ATOMIC_RELAXED, __HIP_MEMORY_SCOPE_AGENT); }
    }
}

struct Args { const float* in[N_IN]; float* out; unsigned char* ws; };

__global__ void __launch_bounds__(NTHR, 2) fwd_kernel(Args a) {
    extern __shared__ __attribute__((aligned(16))) unsigned char lds_raw[];
    LAS unsigned char* lds = (LAS unsigned char*)lds_raw;
    cg::grid_group grid = cg::this_grid();
    const int G = gridDim.x, bx = blockIdx.x, NGW = G * 8, NT = G * NTHR;
    if (threadIdx.x < 64) ((LAS unsigned*)(lds + 131072))[threadIdx.x] = 0u;
    if (bx == 0) for (int i = threadIdx.x; i < XCD_BAR_WORDS; i += NTHR) __hip_atomic_store((unsigned*)(a.ws + 16384) + i, 0u, __ATOMIC_RELAXED, __HIP_MEMORY_SCOPE_AGENT);
    __syncthreads();
    grid.sync();
    const XcdBarrier xbar = xcd_barrier_post((unsigned*)(a.ws + 16384), (volatile LAS unsigned*)(lds + 131072 + 32));
#define GRID_BAR() xcd_barrier(xbar)
#define PHASE_IDS int tid = threadIdx.x; asm volatile("" : "+v"(tid)); const int lane = tid & 63, wave = __builtin_amdgcn_readfirstlane(tid >> 6), gw = bx * 8 + wave, gtid = bx * NTHR + tid; (void)lane; (void)gw; (void)gtid;
    unsigned char* ws = a.ws;
    float* mod = (float*)(ws + OFF_MOD);
    bf16_t* WinT = (bf16_t*)(ws + OFF_WIN); bf16_t* WglaT = (bf16_t*)(ws + OFF_WGLA); bf16_t* WfnT = (bf16_t*)(ws + OFF_WFN); bf16_t* WoT = (bf16_t*)(ws + OFF_WO);
    bf16_t* WupT = (bf16_t*)(ws + OFF_WUP); bf16_t* WdT = (bf16_t*)(ws + OFF_WD); bf16_t* DT = (bf16_t*)(ws + OFF_DT); bf16_t* CS = (bf16_t*)(ws + OFF_CS);
    bf16_t* H1 = (bf16_t*)(ws + OFF_A); bf16_t* XT = H1; bf16_t* Y = H1; bf16_t* H2 = H1;
    bf16_t* Qb = (bf16_t*)(ws + OFF_Q); bf16_t* Kb = (bf16_t*)(ws + OFF_K); bf16_t* Vb = (bf16_t*)(ws + OFF_V); bf16_t* Rb = (bf16_t*)(ws + OFF_R);
    bf16_t* Fb = (bf16_t*)(ws + OFF_F); bf16_t* GA = (bf16_t*)(ws + OFF_GA); bf16_t* GB = (bf16_t*)(ws + OFF_GB); bf16_t* LR = (bf16_t*)(ws + OFF_LR);
    bf16_t* Ff = (bf16_t*)(ws + OFF_FF); bf16_t* Of = (bf16_t*)(ws + OFF_OF); bf16_t* Ob = (bf16_t*)(ws + OFF_OB);
    bf16_t* AG = Qb; bf16_t* U = (bf16_t*)(ws + OFF_U); bf16_t* ACT = (bf16_t*)(ws + OFF_ACT);
    float* out = a.out;

    {
        PHASE_IDS
        LAS float* scr = (LAS float*)(lds + wave * 16384);
        constexpr int IT_IN = 32 * 257, IT_GLA = 16 * 64, IT_FN = 16 * 64, IT_OUT = 32 * 64;
        (void)IT_GLA; (void)IT_FN; (void)IT_OUT;
        for (int it = gw; it < IT_IN; it += NGW) {
            const int r = it, kb = r / 257, nb = r % 257, n0 = nb * 32; const int d0 = n0 < 3072 ? n0 : (n0 == 3072 ? 8192 : n0 - 32);
            transpose_item(a.in[I_WIN], DM, INW, WinT, d0, scr, kb * 64, n0, lane);
        }
        for (int i = gtid; i < 224 * 256; i += NT) ((u32x4*)(WinT + (size_t)8224 * DM))[i] = (u32x4){0u, 0u, 0u, 0u};
        for (int gi = gtid; gi < 2048 * 512; gi += NT) {
            const int k1 = gi >> 9, j0 = (gi & 511) * 8; float v[8];
#pragma unroll
            for (int e = 0; e < 8; ++e) { const int j = j0 + e; const int ph = (k1 * (j & 2047)) & 2047; const float x = (float)ph * (1.0f / 1024.0f); v[e] = j < 2048 ? cospif(x) : -sinpif(x); }
            u32x4 o; o.x = pk2(v[0], v[1]); o.y = pk2(v[2], v[3]); o.z = pk2(v[4], v[5]); o.w = pk2(v[6], v[7]);
            *(u32x4*)(DT + (size_t)k1 * 4096 + j0) = o;
        }
        for (int gi = gtid; gi < 512 * 32; gi += NT) {
            const int m = gi >> 5, c0 = (gi & 31) * 8; float v[8];
#pragma unroll
            for (int e = 0; e < 8; ++e) { const int ph = ((m & 255) * (c0 + e)) & 255; const float x = (float)ph * (1.0f / 128.0f); v[e] = (m < 256 ? cospif(x) : sinpif(x)) * 0.0625f; }
            u32x4 o; o.x = pk2(v[0], v[1]); o.y = pk2(v[2], v[3]); o.z = pk2(v[4], v[5]); o.w = pk2(v[6], v[7]);
            *(u32x4*)(CS + (size_t)m * 256 + c0) = o;
        }
    }
    {
        PHASE_IDS
        LAS float* sl = (LAS float*)lds;
        LAS float* red = sl + 5 * DM;
        __syncthreads();
        for (int i = tid; i < 5 * DM; i += NTHR) { const float c = i < 4 * DM ? a.in[I_C][i] : a.in[I_CCTX][i - 4 * DM]; sl[i] = c * sigmoidf_(c); }
        __syncthreads();
        for (int cb = bx; cb < 256; cb += G) {
            const int col = cb * 48 + (lane < 48 ? lane : 47);
            float acc[5] = {0.f, 0.f, 0.f, 0.f, 0.f};
            const float* wp = a.in[I_WADA] + (size_t)(wave * 256) * MODW + col;
#pragma unroll 16
            for (int kk = 0; kk < 256; ++kk) {
                const float w = wp[(size_t)kk * MODW];
#pragma unroll
                for (int r = 0; r < 5; ++r) acc[r] += w * sl[r * DM + wave * 256 + kk];
            }
            if (lane < 48) {
#pragma unroll
                for (int r = 0; r < 5; ++r) red[(wave * 5 + r) * 48 + lane] = acc[r];
            }
            __syncthreads();
            if (tid < 240) { const int r = tid / 48, c = tid % 48; float s = a.in[I_BADA][cb * 48 + c];
#pragma unroll
                for (int w = 0; w < 8; ++w) s += red[(w * 5 + r) * 48 + c];
                mod[r * MODW + cb * 48 + c] = s; }
            __syncthreads();
        }
    }
    GRID_BAR();

    { PHASE_IDS
    for (int m = gw; m < MT; m += NGW) {
        const float* src = m < M ? a.in[I_X] + (size_t)m * DM : a.in[I_CTX] + (size_t)(m - M) * DM;
        const float* md = mod + (m < M ? (m >> 11) : 4) * MODW;
        f32x4 v[8]; float ss = 0.f;
#pragma unroll
        for (int j = 0; j < 8; ++j) { v[j] = *(const f32x4*)(src + j * 256 + lane * 4); ss += (v[j][0] * v[j][0] + v[j][1] * v[j][1]) + (v[j][2] * v[j][2] + v[j][3] * v[j][3]); }
        const float rstd = rsqrtf(wave_sum(ss) * (1.0f / DM) + EPS);
#pragma unroll
        for (int j = 0; j < 8; ++j) { const int c = j * 256 + lane * 4;
            const f32x4 g = *(const f32x4*)(a.in[I_G1] + c), sh = *(const f32x4*)(md + c), sc = *(const f32x4*)(md + DM + c);
            st_bf4(H1 + (size_t)m * DM + c, (v[j] * rstd * g) * (sc + 1.0f) + sh); }
    } }
    GRID_BAR();

    {
        GemmP g{H1, WinT, DM, DM, DM, 0, 0}; SchedProj S; S.g = SchedGrid{32, 33, 32, G, bx};
        EpiProj E{Qb, Kb, Vb, Rb, Fb, GA, GB, LR};
        gemm_run(lds, g, S, E);
    }
    {
        constexpr int LASTR = 32 * 33 + 28 - 1024;
        const int first = (G == 256) ? LASTR : 0;
        if (bx >= first) {
            PHASE_IDS
            LAS float* scr = (LAS float*)(lds + wave * 16384);
            constexpr int IT_UP = 32 * 352, IT_DN = 88 * 64;
            const int gw2 = (bx - first) * 8 + wave, NGW2 = (G - first) * 8;
            constexpr int IT_GLA = 16 * 64, IT_FN = 16 * 64, IT_OUT = 32 * 64;
            for (int it = gw2; it < IT_UP + IT_GLA + IT_FN + IT_OUT; it += NGW2) {
                int r = it;
                if (r >= IT_UP) { r -= IT_UP;
                    if (r < IT_GLA) { transpose_item(a.in[I_WGLA], VW, DM, WglaT, (r % 64) * 32, scr, (r / 64) * 64, (r % 64) * 32, lane); continue; } r -= IT_GLA;
                    if (r < IT_FN) { transpose_item(a.in[I_WFN], FNW, DM, WfnT, (r % 64) * 32, scr, (r / 64) * 64, (r % 64) * 32, lane); continue; } r -= IT_FN;
                    transpose_item(a.in[I_WOUT], DM, DM, WoT, (r % 64) * 32, scr, (r / 64) * 64, (r % 64) * 32, lane); continue; }
                if (r < IT_UP) { const int n0 = (r % 352) * 32, j = n0 < FF ? n0 : n0 - FF; transpose_item(a.in[I_WUP], DM, F2, WupT, (j >> 7) * 256 + (n0 < FF ? 0 : 128) + (j & 127), scr, (r / 352) * 64, n0, lane); continue; } r -= IT_UP;
                transpose_item(a.in[I_WDN], FF, DM, WdT, (r % 64) * 32, scr, (r / 64) * 64, (r % 64) * 32, lane);
            }
        }
    }
    GRID_BAR();

    {
        GemmP g{CS, Fb, 256, FNW, 256, (long)SEQ * FNW, 256}; SchedGrid S{32, 8, 2, G, bx};
        EpiFn1 E{XT};
        gemm_run(lds, g, S, E);
    }
    GRID_BAR();
    bf16_t* KS = (bf16_t*)out; bf16_t* QD = (bf16_t*)((unsigned char*)out + 18 * MiB); bf16_t* VT = (bf16_t*)((unsigned char*)out + 34 * MiB); float* DEC = (float*)((unsigned char*)out + 52 * MiB);
    if (((bx >> 3) & 3) == 0) {
        const int fj = (bx >> 5) * 8 + (bx & 7);
        { GemmP g{DT, XT, 4096, 4096, 4096, (long)4 * 256 * 4096, (long)256 * 4096}; SchedGrid S{64, 1, 4, 64, fj};
          EpiFn2S E{Ff, 0.02209708691207961f};
          gemm_fast(lds, g, S, E); }
    } else {
        const int gj = (bx >> 5) * 24 + (bx & 31) - 8;
        gla_prep(lds, gj * 6, 6, Qb, Kb, Vb, LR, a.in[I_WGF], a.in[I_BGF], a.in[I_WGB], a.in[I_BGB], KS, QD, VT, DEC, Of, Ob);
    }
    GRID_BAR();
    gla_scan(lds, ((bx & 7) * 4 + (bx >> 6)) * 8 + ((bx >> 3) & 7), G, KS, QD, VT, DEC, Of, Ob);
    GRID_BAR();
    { PHASE_IDS
      for (int task = gw; task < NB * 1023; task += NGW) { const int b = task / 1023, row = 1 + task % 1023;
          const bf16_t* src = Ff + (size_t)(b * SEQ + row) * FNW; bf16_t* dst = Ff + (size_t)(b * SEQ + SEQ - row) * FNW;
#pragma unroll
          for (int g = 0; g < 4; ++g) { const bf16_t* sg = src + g * 256; const int c = 4 * lane;
              const unsigned e0 = sg[(256 - c) & 255], e1 = sg[255 - c], e2 = sg[254 - c], e3 = sg[253 - c];
              u32x2 w; w.x = e0 | (e1 << 16); w.y = e2 | (e3 << 16); *(u32x2*)(dst + g * 256 + c) = w; } }
      for (int task = gw; task < 16 * 256; task += NGW) { const int bz = task >> 8, ch = task & 255;
          const bf16_t* xp = XT + (size_t)bz * 256 * 4096 + (size_t)ch * 4096; float sacc = 0.f;
#pragma unroll
          for (int it = 0; it < 4; ++it) { const bf16x8 xv = *(const bf16x8*)(xp + it * 512 + lane * 8);
#pragma unroll
              for (int e = 0; e < 8; e += 2) sacc += bf2f((unsigned short)xv[e]) - bf2f((unsigned short)xv[e + 1]); }
          sacc = wave_sum(sacc);
          if (lane == 0) Ff[(size_t)((bz >> 2) * SEQ + 1024) * FNW + (bz & 3) * 256 + ch] = (bf16_t)f2bfhw(sacc * 0.02209708691207961f); } }
    { PHASE_IDS
    for (int it = 0; it < (G == 256 ? 1 : 0); ++it) { const int lt = (bx >> 3) * 8 + wave, bhx = 2 * (bx & 7) + (lt >> 7), h = bhx & 3, b = bhx >> 2, n = (lt >> 2) & 31, ct = lt & 3, fr = lane & 15, fq = lane >> 4;
        f32x4 ov[16]; float ss = 0.f;
#pragma unroll
        for (int t = 0; t < 16; ++t) { const size_t o = ((((((size_t)(b * 32 + n) * 4 + h) * 8 + (t >> 1)) * 4 + ct) * 2 + (t & 1)) * 64 + lane) << 2;
            const f32x4 x = ld_bf4(Of + o) + ld_bf4(Ob + o); ov[t] = x; ss += (x[0] * x[0] + x[1] * x[1]) + (x[2] * x[2] + x[3] * x[3]); }
        ss += __shfl_xor(ss, 16); ss += __shfl_xor(ss, 32);
        const float rstd = rsqrtf(ss * (1.0f / DV) + EPS);
        const size_t ro = (size_t)(b * SEQ + n * 64 + 16 * ct + fr) * VW + h * DV + 4 * fq;
#pragma unroll
        for (int t = 0; t < 16; ++t) { const f32x4 gg = *(const f32x4*)(a.in[I_GGLA] + h * DV + t * 16 + 4 * fq);
            st_bf4(AG + ro + t * 16, ld_bf4(Rb + ro + t * 16) * (ov[t] * rstd * gg)); }
    } }
    GRID_BAR();

    {
        GemmP g{AG, WglaT, VW, VW, VW, 0, (long)((OFF_WFN - OFF_WGLA) / 2), (long)((OFF_FF - OFF_Q) / 2)}; SchedPair S; S.g = SchedGrid{32, 8, 32, G, bx};
        EpiYab E{GA, GB, out, Y};
        gemm_fast(lds, g, S, E);
    }
    GRID_BAR();
    float* slots1 = (float*)(ws + 320 * 1024); float* slots2 = (float*)(ws + 576 * 1024);
    {
        f32x4 xr[2][16]; Unit u;
        { f32x4 acc[2][2][4][2];
          { GemmP g{Y, WoT, DM, DM, DM, 0, 0}; SchedGrid S{32, 8, 32, G, bx}; gemm_fast_core<EpiNone, SchedGrid, true>(lds, g, S, EpiNone{}, acc, u); }
          epi_rows_part1<2, 2, false>(lds, acc, u, a.in[I_X], mod, out, slots1, xr); }
        xcd_barrier_light(xbar);
        int tid2 = threadIdx.x; asm volatile("" : "+v"(tid2));
        { const int wid2 = __builtin_amdgcn_readfirstlane(tid2 >> 6), colg = u.pn * BM + 4 * (tid2 & 63); const float* md = mod + ((u.pm * BM) >> 11) * MODW;
          const f32x4 gg = *(const f32x4*)(a.in[I_G2] + colg), sh = *(const f32x4*)(md + 3 * DM + colg), sc = *(const f32x4*)(md + 4 * DM + colg) + 1.0f;
#pragma unroll
          for (int ai = 0; ai < 2; ++ai)
#pragma unroll
              for (int j = 0; j < 16; ++j) { const int row = u.pm * BM + ai * HALF + wid2 * 16 + j; const float rstd = row_rstd(slots1, row);
                  st_bf4(H2 + (size_t)row * DM + colg, (xr[ai][j] * rstd * gg) * sc + sh); }
        }
    }
    GRID_BAR();
    {
        GemmP g{H2, WupT, DM, DM, DM, 0, 0}; SchedGrid S{32, 44, 32, G, bx};
        EpiUpConv E{a.in[I_CW], a.in[I_CB], ACT};
#if GEMM_FAST
        gemm_fast(lds, g, S, E);
#endif
    }
    if (bx >= 128) {
        PHASE_IDS
        LAS float* scr = (LAS float*)(lds + wave * 16384);
        for (int r = (bx - 128) * 8 + wave; r < 88 * 64; r += (G - 128) * 8)
            transpose_item(a.in[I_WDN], FF, DM, WdT, (r % 64) * 32, scr, (r / 64) * 64, (r % 64) * 32, lane);
    }
    GRID_BAR();
    {
        f32x4 xr[2][16]; Unit u;
        { f32x4 acc[2][2][4][2];
          { GemmP g{ACT, WdT, FF, FF, FF, 0, 0}; SchedGrid S{32, 8, 32, G, bx}; gemm_fast_core<EpiNone, SchedGrid, true>(lds, g, S, EpiNone{}, acc, u); }
          epi_rows_part1<5, 0, true>(lds, acc, u, out, mod, out, slots2, xr); }
        xcd_barrier_light(xbar);
        int tid2 = threadIdx.x; asm volatile("" : "+v"(tid2));
        { const int wid2 = __builtin_amdgcn_readfirstlane(tid2 >> 6), colg = u.pn * BM + 4 * (tid2 & 63);
          const f32x4 gf = *(const f32x4*)(a.in[I_GF] + colg);
#pragma unroll
          for (int ai = 0; ai < 2; ++ai)
#pragma unroll
              for (int j = 0; j < 16; ++j) { const int row = u.pm * BM + ai * HALF + wid2 * 16 + j; const float rstd = row_rstd(slots2, row);
                  *(f32x4*)(out + (size_t)row * DM + colg) = xr[ai][j] * rstd * gf; }
        }
    }
}

extern "C" void kernel_launch(void* const* d_in, const int* in_sizes, int n_in, void* d_out, int out_size, void* d_ws, size_t ws_size, hipStream_t stream) {
    static int grid = 0;
    if (grid == 0) {
        if (n_in != N_IN || out_size != M * DM || ws_size < WS_END) { fprintf(stderr, "kernel_launch: unexpected shapes: n_in %d out %d ws %zu (need %zu)\n", n_in, out_size, ws_size, (size_t)WS_END); grid = -1; return; }
        int dev = 0, cus = 0, per_cu = 0;
        (void)hipGetDevice(&dev);
        (void)hipDeviceGetAttribute(&cus, hipDeviceAttributeMultiprocessorCount, dev);
        if (hipFuncSetAttribute((const void*)fwd_kernel, hipFuncAttributeMaxDynamicSharedMemorySize, LDS_BYTES) != hipSuccess) { fprintf(stderr, "kernel_launch: hipFuncSetAttribute failed\n"); grid = -1; return; }
        (void)hipOccupancyMaxActiveBlocksPerMultiprocessor(&per_cu, (const void*)fwd_kernel, NTHR, LDS_BYTES);
        if (per_cu < 1) { fprintf(stderr, "kernel_launch: occupancy query reports %d blocks per CU\n", per_cu); grid = -1; return; }
        if (cus != 256) { fprintf(stderr, "kernel_launch: built for a 256-CU device (one 256x256 unit per workgroup in the fused-norm GEMM phases), got %d\n", cus); grid = -1; return; }
        grid = cus;
    }
    if (grid < 0) return;
    Args a{};
    for (int i = 0; i < N_IN; ++i) a.in[i] = (const float*)d_in[i];
    a.out = (float*)d_out; a.ws = (unsigned char*)d_ws;
    void* args[] = {&a};
    hipError_t e = hipLaunchCooperativeKernel((const void*)fwd_kernel, dim3(grid), dim3(NTHR), args, LDS_BYTES, stream);
    if (e != hipSuccess) fprintf(stderr, "kernel_launch: cooperative launch failed: %s (grid %d)\n", hipGetErrorString(e), grid);
}
```
